# Optimizing an MI355X kernel written in HIP

```python
import jax, jax.numpy as jnp
from jax import lax
import numpy as np

D_MODEL = 1024
BATCH = 8
SEQ = 2048
DEPTH = 4

EPS_RMS = 1e-6
EPS_LN = 1e-5
W_CONV = D_MODEL
CONV_K = 31
W_POOL = D_MODEL
POOL_WINDOWS = (2, 4, 8, 16)
POOL_GROUPS = len(POOL_WINDOWS)
POOL_GW = W_POOL // POOL_GROUPS
W_EVEN_IN = 3 * W_CONV + 2 * W_POOL
W_EVEN_MIX = W_CONV + W_POOL
LRU_HEADS = 12
LRU_HD = 128
W_LRU = LRU_HEADS * LRU_HD
LRU_CONV_K = 4
LRU_C = 8.0
N_EVEN = (DEPTH + 1) // 2
N_ODD = DEPTH // 2

kernel_name = "hybrid_conv_pool_rglru_trunk"


def rmsnorm(x, g):
    xf = x.astype(jnp.float32)
    y = xf * lax.rsqrt(jnp.mean(xf * xf, axis=-1, keepdims=True) + EPS_RMS)
    return (y * g.astype(jnp.float32)).astype(x.dtype)


def layernorm(x, g, b):
    xf = x.astype(jnp.float32)
    mu = jnp.mean(xf, axis=-1, keepdims=True)
    var = jnp.mean(jnp.square(xf - mu), axis=-1, keepdims=True)
    y = (xf - mu) * lax.rsqrt(var + EPS_LN)
    return (y * g.astype(jnp.float32) + b.astype(jnp.float32)).astype(x.dtype)


def causal_depthwise_conv(x, w, b):
    k = w.shape[0]
    y = lax.conv_general_dilated(
        x, w[:, None, :].astype(x.dtype), window_strides=(1,), padding=[(k - 1, 0)],
        dimension_numbers=("NWC", "WIO", "NWC"), feature_group_count=x.shape[-1])
    return y + b.astype(x.dtype)


def multiscale_pool_diff(v):
    bsz, t, _ = v.shape
    vf = v.astype(jnp.float32)
    cs_pad = jnp.pad(jnp.cumsum(vf, axis=1), ((0, 0), (1, 0), (0, 0)))
    pos = jnp.arange(1, t + 1, dtype=jnp.float32)
    outs = []
    for g, w in enumerate(POOL_WINDOWS):
        seg = cs_pad[:, :, g * POOL_GW:(g + 1) * POOL_GW]
        upper = seg[:, 1:]
        lower = jnp.pad(seg[:, :t - w + 1], ((0, 0), (w - 1, 0), (0, 0)))
        cnt = jnp.minimum(pos, jnp.float32(w))[None, :, None]
        outs.append((upper - lower) / cnt)
    return jnp.concatenate(outs, axis=-1) - vf


def even_mixer(h, w_in, conv_w, conv_b, ln_g, ln_b, pool_w, pool_b, pool_scale, w_out):
    bsz, t, _ = h.shape
    p = jnp.einsum("btd,dn->btn", h, w_in)
    a_val, a_glu, a_gate, b_val, b_gate = jnp.split(
        p, [W_CONV, 2 * W_CONV, 3 * W_CONV, 3 * W_CONV + W_POOL], axis=-1)
    u = a_val * jax.nn.sigmoid(a_glu)
    u = causal_depthwise_conv(u, conv_w, conv_b)
    u = jax.nn.silu(layernorm(u, ln_g, ln_b))
    ya = u * jax.nn.silu(a_gate)
    d = multiscale_pool_diff(b_val).reshape(bsz, t, POOL_GROUPS, POOL_GW)
    d = jnp.einsum("btgc,gce->btge", d, pool_w.astype(jnp.float32)) + pool_b.astype(jnp.float32)
    yb = (d.reshape(bsz, t, W_POOL) * pool_scale.astype(jnp.float32)).astype(h.dtype)
    yb = yb * jax.nn.silu(b_gate)
    y = jnp.concatenate([ya, yb], axis=-1)
    return jnp.einsum("btn,nd->btd", y, w_out)


def _lin_combine(c1, c2):
    a1, b1 = c1
    a2, b2 = c2
    return a1 * a2, a2 * b1 + b2


def odd_mixer(h, w_in, conv_w, conv_b, w_rg, b_rg, w_ig, b_ig, lam, w_out):
    bsz, t, _ = h.shape
    p = jnp.einsum("btd,dn->btn", h, w_in)
    xr, gate = jnp.split(p, [W_LRU], axis=-1)
    xc = causal_depthwise_conv(xr, conv_w, conv_b)
    xh = xc.reshape(bsz, t, LRU_HEADS, LRU_HD)
    r = jax.nn.sigmoid(jnp.einsum("bthi,hij->bthj", xh, w_rg).reshape(bsz, t, W_LRU).astype(jnp.float32)
                       + b_rg.astype(jnp.float32))
    i = jax.nn.sigmoid(jnp.einsum("bthi,hij->bthj", xh, w_ig).reshape(bsz, t, W_LRU).astype(jnp.float32)
                       + b_ig.astype(jnp.float32))
    log_a = -LRU_C * r * jax.nn.softplus(-lam.astype(jnp.float32))
    a = jnp.exp(log_a)
    mult = jnp.sqrt(-jnp.expm1(2.0 * log_a))
    bterm = mult * (i * xc.astype(jnp.float32))
    _, hs = lax.associative_scan(_lin_combine, (a, bterm), axis=1)
    y = hs.astype(h.dtype) * jax.nn.silu(gate)
    return jnp.einsum("btn,nd->btd", y, w_out)


def setup_inputs(seed: int = 0) -> dict:
    key = jax.random.key(seed)
    ks = iter(jax.random.split(key, 32))
    f32 = jnp.float32

    def nrm(shape, scale):
        return jax.random.normal(next(ks), shape, f32) * scale

    x = jax.random.normal(next(ks), (BATCH, SEQ, D_MODEL), f32)
    a0 = jax.random.uniform(next(ks), (N_ODD, W_LRU), f32, 0.9, 0.999)
    s = a0 ** (1.0 / LRU_C)
    lru_lambda = jnp.log(s) - jnp.log1p(-s)
    return {
        "x": x,
        "norm_even": 1.0 + nrm((N_EVEN, D_MODEL), 0.02),
        "w_in_even": nrm((N_EVEN, D_MODEL, W_EVEN_IN), D_MODEL ** -0.5),
        "conv_a_w": nrm((N_EVEN, CONV_K, W_CONV), CONV_K ** -0.5),
        "conv_a_b": nrm((N_EVEN, W_CONV), 0.01),
        "ln_a_g": 1.0 + nrm((N_EVEN, W_CONV), 0.02),
        "ln_a_b": nrm((N_EVEN, W_CONV), 0.01),
        "pool_w": nrm((N_EVEN, POOL_GROUPS, POOL_GW, POOL_GW), POOL_GW ** -0.5),
        "pool_b": nrm((N_EVEN, POOL_GROUPS, POOL_GW), 0.01),
        "pool_scale": 1.0 + nrm((N_EVEN, W_POOL), 0.1),
        "w_out_even": nrm((N_EVEN, W_EVEN_MIX, D_MODEL), W_EVEN_MIX ** -0.5),
        "norm_odd": 1.0 + nrm((N_ODD, D_MODEL), 0.02),
        "w_in_odd": nrm((N_ODD, D_MODEL, 2 * W_LRU), D_MODEL ** -0.5),
        "conv_c_w": nrm((N_ODD, LRU_CONV_K, W_LRU), LRU_CONV_K ** -0.5),
        "conv_c_b": nrm((N_ODD, W_LRU), 0.01),
        "w_rg": nrm((N_ODD, LRU_HEADS, LRU_HD, LRU_HD), LRU_HD ** -0.5),
        "b_rg": nrm((N_ODD, W_LRU), 0.01),
        "w_ig": nrm((N_ODD, LRU_HEADS, LRU_HD, LRU_HD), LRU_HD ** -0.5),
        "b_ig": nrm((N_ODD, W_LRU), 0.01),
        "lru_lambda": lru_lambda,
        "w_out_odd": nrm((N_ODD, W_LRU, D_MODEL), W_LRU ** -0.5),
        "final_norm": 1.0 + nrm((D_MODEL,), 0.02),
    }


def reference(x, norm_even, w_in_even, conv_a_w, conv_a_b, ln_a_g, ln_a_b, pool_w, pool_b,
              pool_scale, w_out_even, norm_odd, w_in_odd, conv_c_w, conv_c_b, w_rg, b_rg,
              w_ig, b_ig, lru_lambda, w_out_odd, final_norm):
    h = x
    for layer in range(DEPTH):
        if layer % 2 == 0:
            j = layer // 2
            h = h + even_mixer(rmsnorm(h, norm_even[j]), w_in_even[j], conv_a_w[j], conv_a_b[j],
                               ln_a_g[j], ln_a_b[j], pool_w[j], pool_b[j], pool_scale[j],
                               w_out_even[j])
        else:
            j = layer // 2
            h = h + odd_mixer(rmsnorm(h, norm_odd[j]), w_in_odd[j], conv_c_w[j], conv_c_b[j],
                              w_rg[j], b_rg[j], w_ig[j], b_ig[j], lru_lambda[j], w_out_odd[j])
    return rmsnorm(h, final_norm)
```

```cpp
#include <hip/hip_runtime.h>
#include <cstdio>
#include <cstdint>
namespace pg8 {
#define PG8_LAS __attribute__((address_space(3)))
typedef unsigned short bf16_t;
typedef short bf16x8 __attribute__((ext_vector_type(8)));
typedef float f32x4 __attribute__((ext_vector_type(4)));
typedef unsigned u32x4 __attribute__((ext_vector_type(4)));
constexpr int BM = 256, BK = 64, HALF = 128, HTB = HALF * BK * 2  , STAGE_BYTES = 8 * HTB, NXCD = 8, WGM = 8;

__host__ __device__ __forceinline__ int lds_byte(int r, int c) { const int st = (r >> 4) * 2 + (c >> 5), rr = r & 15, cc = c & 31, ob = rr * 64 + cc * 2; return st * 1024 + (ob ^ (((ob >> 9) & 1) << 5)); }
__host__ __device__ __forceinline__ void stage_rc(int b, int& R, int& C) { const int st = b / 1024, sb = b % 1024, swz = sb ^ (((sb >> 9) & 1) << 5); R = (st >> 1) * 16 + swz / 64; C = (st & 1) * 32 + (swz % 64) / 2; }
__host__ __device__ __forceinline__ int perm32(int rho) { const int n = rho >> 4, i = rho & 15; return 8 * (i >> 2) + 4 * n + (i & 3); }

struct Unit { int pm, pn; };
struct Gemm { const bf16_t* A; const bf16_t* Bt; int M, N, K; };

struct StaticOrder {
    int nM, nN, nwg, G, c;
    __host__ __device__ void init(int M, int N, int G_, int c_) { nM = M / BM; nN = N / BM; nwg = nM * nN; G = G_; c = c_; }
    __host__ __device__ bool next(int i, Unit& u) const {
        const long L = (long)i * G + c; if (L >= nwg) return false;
        int wgid = (int)L; { const int q = nwg / NXCD, r = nwg % NXCD, xcd = wgid % NXCD, off = wgid / NXCD; wgid = (xcd < r ? xcd * (q + 1) : r * (q + 1) + (xcd - r) * q) + off; }
        const int nig = WGM * nN, gid = wgid / nig, fm = gid * WGM, gsz = (nM - fm) < WGM ? (nM - fm) : WGM;
        u.pm = fm + ((wgid % nig) % gsz); u.pn = (wgid % nig) / gsz; return true;
    }
    __device__ __forceinline__ void a_ready(const Unit&) const {}
    __device__ __forceinline__ void done(const Unit&) const {}
};
__device__ __forceinline__ unsigned cvt_pk_bf16(float lo, float hi) { unsigned r; asm volatile("v_cvt_pk_bf16_f32 %0, %1, %2" : "=v"(r) : "v"(lo), "v"(hi)); return r; }
__device__ __forceinline__ float sigm(float x) { return __builtin_amdgcn_rcpf(1.0f + __expf(-x)); }
constexpr int MROWS = 16384;
__device__ __forceinline__ f32x4 sigm4(f32x4 v) { const f32x4 z = v * (-1.44269504f); f32x4 e; e[0] = __builtin_amdgcn_exp2f(z[0]); e[1] = __builtin_amdgcn_exp2f(z[1]); e[2] = __builtin_amdgcn_exp2f(z[2]); e[3] = __builtin_amdgcn_exp2f(z[3]);
    const f32x4 d = e + 1.0f; f32x4 r; r[0] = __builtin_amdgcn_rcpf(d[0]); r[1] = __builtin_amdgcn_rcpf(d[1]); r[2] = __builtin_amdgcn_rcpf(d[2]); r[3] = __builtin_amdgcn_rcpf(d[3]); return r; }

struct EpiE1 {
    static constexpr bool PERM = true, AFTER_DRAIN = false;
    const PG8_LAS float* rsl; bf16_t* U;
    __device__ __forceinline__ void operator()(const f32x4 (&acc)[2][2][4][2], const Unit& u, int wr, int wc, int fr, int fq) const {
        const int row0 = u.pm * BM + wr * 64 + fr, c8 = wc * 32 + 8 * fq;
        float rs[2][4];
#pragma unroll
        for (int ai = 0; ai < 2; ++ai)
#pragma unroll
            for (int m = 0; m < 4; ++m) rs[ai][m] = rsl[wr * 64 + ai * HALF + m * 16 + fr];
        if (u.pn < 8) {
#pragma unroll
            for (int ai = 0; ai < 2; ++ai)
#pragma unroll
                for (int m = 0; m < 4; ++m) { const float r = rs[ai][m]; bf16_t* rowp = U + (size_t)(row0 + ai * HALF + m * 16) * 1024 + u.pn * 128 + c8;
                    const f32x4 o0 = (acc[ai][0][m][0] * r) * sigm4(acc[ai][1][m][0] * r), o1 = (acc[ai][0][m][1] * r) * sigm4(acc[ai][1][m][1] * r);
                    u32x4 w; w.x = cvt_pk_bf16(o0[0], o0[1]); w.y = cvt_pk_bf16(o0[2], o0[3]); w.z = cvt_pk_bf16(o1[0], o1[1]); w.w = cvt_pk_bf16(o1[2], o1[3]);
                    *(u32x4*)rowp = w; }
        } else {
            const bool act = (u.pn < 12) || (u.pn >= 16); const bool isbv = !act;
            const int ldc = isbv ? 1024 : 2048, colt = (u.pn < 12) ? (u.pn - 8) * 256 : (isbv ? (u.pn - 12) * 256 : 1024 + (u.pn - 16) * 256);
            bf16_t* base = U + (isbv ? (size_t)16 * 1024 * 1024 : (size_t)32 * 1024 * 1024);
#pragma unroll
            for (int ai = 0; ai < 2; ++ai)
#pragma unroll
                for (int m = 0; m < 4; ++m) { const float r = rs[ai][m]; bf16_t* rowp = base + (size_t)(row0 + ai * HALF + m * 16) * ldc + colt + c8;
#pragma unroll
                    for (int bj = 0; bj < 2; ++bj) { f32x4 o0 = acc[ai][bj][m][0] * r, o1 = acc[ai][bj][m][1] * r;
                        if (act) { o0 = o0 * sigm4(o0); o1 = o1 * sigm4(o1); }
                        u32x4 w; w.x = cvt_pk_bf16(o0[0], o0[1]); w.y = cvt_pk_bf16(o0[2], o0[3]); w.z = cvt_pk_bf16(o1[0], o1[1]); w.w = cvt_pk_bf16(o1[2], o1[3]);
                        *(u32x4*)(rowp + bj * HALF) = w; } }
        }
    }
};
struct EpiO1 {
    static constexpr bool PERM = true, AFTER_DRAIN = false;
    const PG8_LAS float* rsl; bf16_t* XR;
    __device__ __forceinline__ void operator()(const f32x4 (&acc)[2][2][4][2], const Unit& u, int wr, int wc, int fr, int fq) const {
        const int row0 = u.pm * BM + wr * 64 + fr, c8 = wc * 32 + 8 * fq;
        float rs[2][4];
#pragma unroll
        for (int ai = 0; ai < 2; ++ai)
#pragma unroll
            for (int m = 0; m < 4; ++m) rs[ai][m] = rsl[wr * 64 + ai * HALF + m * 16 + fr];
        const bool act = u.pn >= 6;
        bf16_t* base = XR + (act ? (size_t)24 * 1024 * 1024 : (size_t)0); const int colt = (act ? u.pn - 6 : u.pn) * 256;
#pragma unroll
        for (int ai = 0; ai < 2; ++ai)
#pragma unroll
            for (int m = 0; m < 4; ++m) { const float r = rs[ai][m]; bf16_t* rowp = base + (size_t)(row0 + ai * HALF + m * 16) * 1536 + colt + c8;
#pragma unroll
                for (int bj = 0; bj < 2; ++bj) { f32x4 o0 = acc[ai][bj][m][0] * r, o1 = acc[ai][bj][m][1] * r;
                    if (act) { o0 = o0 * sigm4(o0); o1 = o1 * sigm4(o1); }
                    u32x4 w; w.x = cvt_pk_bf16(o0[0], o0[1]); w.y = cvt_pk_bf16(o0[2], o0[3]); w.z = cvt_pk_bf16(o1[0], o1[1]); w.w = cvt_pk_bf16(o1[2], o1[3]);
                    *(u32x4*)(rowp + bj * HALF) = w; } }
    }
};
struct EpiRes {
    static constexpr bool PERM = true, AFTER_DRAIN = false;
    bf16_t* HB; float* ssq;
    __device__ __forceinline__ void operator()(const f32x4 (&acc)[2][2][4][2], const Unit& u, int wr, int wc, int fr, int fq) const {
        const int row0 = u.pm * BM + wr * 64 + fr, col0 = u.pn * BM + wc * 32 + 8 * fq;
#pragma unroll
        for (int ai = 0; ai < 2; ++ai)
#pragma unroll
            for (int m = 0; m < 4; ++m) { const int row = row0 + ai * HALF + m * 16; bf16_t* rowp = HB + (size_t)row * 1024 + col0; float s = 0.f;
#pragma unroll
                for (int bj = 0; bj < 2; ++bj) { const u32x4 b = *(const u32x4*)(rowp + bj * HALF); float o[8];
                    const float bb[8] = {__uint_as_float(b.x << 16), __uint_as_float(b.x & 0xffff0000u), __uint_as_float(b.y << 16), __uint_as_float(b.y & 0xffff0000u),
                                         __uint_as_float(b.z << 16), __uint_as_float(b.z & 0xffff0000u), __uint_as_float(b.w << 16), __uint_as_float(b.w & 0xffff0000u)};
#pragma unroll
                    for (int n = 0; n < 2; ++n)
#pragma unroll
                        for (int e = 0; e < 4; ++e) { o[4 * n + e] = bb[4 * n + e] + acc[ai][bj][m][n][e]; s += o[4 * n + e] * o[4 * n + e]; }
                    u32x4 w; w.x = cvt_pk_bf16(o[0], o[1]); w.y = cvt_pk_bf16(o[2], o[3]); w.z = cvt_pk_bf16(o[4], o[5]); w.w = cvt_pk_bf16(o[6], o[7]);
                    *(u32x4*)(rowp + bj * HALF) = w; }
                s += __shfl_xor(s, 16); s += __shfl_xor(s, 32);
                if (fq == 0) ssq[(size_t)(u.pn * 4 + wc) * MROWS + row] = s; }
    }
};
struct EpiFinal {
    static constexpr bool PERM = true, AFTER_DRAIN = true;
    const bf16_t* HB; float* out; const float* gain; float* xbuf; unsigned* cnt; unsigned* tmo;
    __device__ __forceinline__ void fused(f32x4 (&acc)[2][2][4][2], const Unit& u, int wr, int wc, int fr, int fq, PG8_LAS unsigned char* lds, int wid, int lane) const {
        PG8_LAS float* P = (PG8_LAS float*)lds;
        PG8_LAS float* R = (PG8_LAS float*)(lds + 4096);
        const int row0 = u.pm * BM + wr * 64 + fr, col0 = u.pn * BM + wc * 32 + 8 * fq;
#pragma unroll
        for (int ai = 0; ai < 2; ++ai)
#pragma unroll
            for (int m = 0; m < 4; ++m) { const int row = row0 + ai * HALF + m * 16; const bf16_t* rowp = HB + (size_t)row * 1024 + col0; float s = 0.f;
#pragma unroll
                for (int bj = 0; bj < 2; ++bj) { const u32x4 b = *(const u32x4*)(rowp + bj * HALF);
                    const f32x4 b0 = (f32x4){__uint_as_float(b.x << 16), __uint_as_float(b.x & 0xffff0000u), __uint_as_float(b.y << 16), __uint_as_float(b.y & 0xffff0000u)};
                    const f32x4 b1 = (f32x4){__uint_as_float(b.z << 16), __uint_as_float(b.z & 0xffff0000u), __uint_as_float(b.w << 16), __uint_as_float(b.w & 0xffff0000u)};
                    acc[ai][bj][m][0] += b0; acc[ai][bj][m][1] += b1;
                    const f32x4 q0 = acc[ai][bj][m][0] * acc[ai][bj][m][0], q1 = acc[ai][bj][m][1] * acc[ai][bj][m][1];
                    s += ((q0[0] + q0[1]) + (q0[2] + q0[3])) + ((q1[0] + q1[1]) + (q1[2] + q1[3])); }
                s += __shfl_xor(s, 16); s += __shfl_xor(s, 32);
                if (fq == 0) P[(wr * 64 + ai * HALF + m * 16 + fr) * 4 + wc] = s; }
        asm volatile("s_waitcnt lgkmcnt(0)" ::: "memory"); __builtin_amdgcn_s_barrier(); asm volatile("" ::: "memory");
        const int row = wid * 32 + (lane & 31);
        if (lane < 32) { const float t = (P[row * 4 + 0] + P[row * 4 + 1]) + (P[row * 4 + 2] + P[row * 4 + 3]);
            __hip_atomic_store(xbuf + (size_t)(u.pm * BM + row) * 4 + u.pn, t, __ATOMIC_RELAXED, __HIP_MEMORY_SCOPE_AGENT); }
        asm volatile("s_waitcnt vmcnt(0)" ::: "memory");
        if (lane == 0) __hip_atomic_fetch_add(cnt + 64 * u.pm, 1u, __ATOMIC_RELAXED, __HIP_MEMORY_SCOPE_AGENT);
        if (wid == 0) { unsigned spins = 0u;
            while ((unsigned)__builtin_amdgcn_readfirstlane(__hip_atomic_load(cnt + 64 * u.pm, __ATOMIC_RELAXED, __HIP_MEMORY_SCOPE_AGENT)) < 32u) {
                __builtin_amdgcn_s_sleep(1);
                if ((++spins & 255u) == 0u) { if (__hip_atomic_load(tmo, __ATOMIC_RELAXED, __HIP_MEMORY_SCOPE_AGENT) != 0u) break; if (spins > (1u << 19)) { if (lane == 0) __hip_atomic_store(tmo, 1u, __ATOMIC_RELAXED, __HIP_MEMORY_SCOPE_AGENT); break; } } }
            __builtin_amdgcn_fence(__ATOMIC_ACQUIRE, "agent"); }
        asm volatile("s_waitcnt vmcnt(0) lgkmcnt(0)" ::: "memory"); __builtin_amdgcn_s_barrier(); asm volatile("" ::: "memory");
        if (lane < 32) { const float* xs = xbuf + (size_t)(u.pm * BM + row) * 4; float t = 0.f;
#pragma unroll
            for (int k = 0; k < 4; ++k) t += __hip_atomic_load(xs + k, __ATOMIC_RELAXED, __HIP_MEMORY_SCOPE_AGENT);
            R[row] = rsqrtf(t * (1.0f / 1024.0f) + 1e-6f); }
        asm volatile("s_waitcnt lgkmcnt(0)" ::: "memory"); __builtin_amdgcn_s_barrier(); asm volatile("" ::: "memory");
        f32x4 gv[2][2];
#pragma unroll
        for (int bj = 0; bj < 2; ++bj)
#pragma unroll
            for (int n = 0; n < 2; ++n) gv[bj][n] = *(const f32x4*)(gain + col0 + bj * HALF + 4 * n);
#pragma unroll
        for (int ai = 0; ai < 2; ++ai)
#pragma unroll
            for (int m = 0; m < 4; ++m) { const int rl = wr * 64 + ai * HALF + m * 16 + fr; const float r = R[rl]; float* op = out + (size_t)(u.pm * BM + rl) * 1024 + col0;
#pragma unroll
                for (int bj = 0; bj < 2; ++bj)
#pragma unroll
                    for (int n = 0; n < 2; ++n) *(f32x4*)(op + bj * HALF + 4 * n) = acc[ai][bj][m][n] * r * gv[bj][n]; }
    }
};
template <class Epi, class Sched, bool ALIGN_EPI = false, bool SP2 = false>
__device__ __forceinline__ void gemm_phase(PG8_LAS unsigned char* lds, const Gemm g, const Sched& S, const Epi& E, const int tid_in) {
    int tid_ = tid_in; asm volatile("" : "+v"(tid_));
    const int tid = tid_, wid = __builtin_amdgcn_readfirstlane(tid >> 6), lane = tid & 63, wr = wid >> 2, wc = wid & 3, fr = lane & 15, fq = lane >> 4;
    const int K = g.K, nt = K / BK;
    unsigned voffA[2], voffB[2];
#pragma unroll
    for (int i = 0; i < 2; ++i) { int R, C; stage_rc(tid * 16 + i * 8192, R, C); const int Rb = Epi::PERM ? ((R & ~31) + perm32(R & 31)) : R;
        voffA[i] = (unsigned)(R * K + C) * 2u; voffB[i] = (unsigned)(Rb * K + C) * 2u; }
    const size_t kstep = (size_t)(BK * 2);
    const size_t hstep = (size_t)HALF * K * 2;
    const size_t tstep = 2 * hstep;
    const unsigned ldsw = (unsigned)wid * 1024u;
    const int aoff = lds_byte(wr * 64 + fr, fq * 8), boff = lds_byte(wc * 32 + fr, fq * 8);
#define PG8_SA(b, h) (((b) * 2 + (h)) * HTB)
#define PG8_SB(b, h) ((4 + (b) * 2 + (h)) * HTB)
#define PG8_STAGE(bufoff, gbase, voff) do { _Pragma("unroll") for (int _i = 0; _i < 2; ++_i) \
        __builtin_amdgcn_global_load_lds((const unsigned*)((const char*)(gbase) + (voff)[_i]), (PG8_LAS unsigned*)(lds + (bufoff) + ldsw + _i * 8192), 16, 0, 0); } while (0)
#define PG8_LDA(dst, b, h) do { _Pragma("unroll") for (int m = 0; m < 4; ++m) _Pragma("unroll") for (int k = 0; k < 2; ++k) dst[m][k] = *(const PG8_LAS bf16x8*)(lds + PG8_SA(b, h) + aoff + m * 2048 + k * 1024); } while (0)
#define PG8_LDB(dst, b, h) do { _Pragma("unroll") for (int n = 0; n < 2; ++n) _Pragma("unroll") for (int k = 0; k < 2; ++k) dst[n][k] = *(const PG8_LAS bf16x8*)(lds + PG8_SB(b, h) + boff + n * 2048 + k * 1024); } while (0)
#define PG8_MMA(ai, bj, At, Bt) do { __builtin_amdgcn_s_setprio(1); _Pragma("unroll") for (int m = 0; m < 4; ++m) _Pragma("unroll") for (int n = 0; n < 2; ++n) _Pragma("unroll") for (int k = 0; k < 2; ++k) \
        acc[ai][bj][m][n] = __builtin_amdgcn_mfma_f32_16x16x32_bf16(Bt[n][k], At[m][k], acc[ai][bj][m][n], 0, 0, 0); __builtin_amdgcn_s_setprio(0); } while (0)
#define PG8_WAIT_V(n) asm volatile("s_waitcnt vmcnt(" #n ")" ::: "memory")
#define PG8_WAIT_L(n) asm volatile("s_waitcnt lgkmcnt(" #n ")" ::: "memory")
#define PG8_BAR __builtin_amdgcn_s_barrier()
#define PG8_SCHED __builtin_amdgcn_sched_barrier(0)
    Unit cur, nxt; int ui = 0;
    if (!S.next(0, cur)) return;
    f32x4 acc[2][2][4][2];
#pragma unroll
    for (int a = 0; a < 2; ++a)
#pragma unroll
        for (int b = 0; b < 2; ++b)
#pragma unroll
            for (int m = 0; m < 4; ++m)
#pragma unroll
                for (int n = 0; n < 2; ++n) acc[a][b][m][n] = (f32x4){0.f, 0.f, 0.f, 0.f};
    bf16x8 At[4][2], B0[2][2], B1[2][2];
    const char* cA = (const char*)g.A + (size_t)cur.pm * tstep; const char* cB = (const char*)g.Bt + (size_t)cur.pn * tstep;
    S.a_ready(cur);
    if constexpr (SP2) {
        PG8_STAGE(PG8_SB(0, 0), cB, voffB); PG8_STAGE(PG8_SB(0, 1), cB + hstep, voffB); PG8_STAGE(PG8_SA(0, 0), cA, voffA); PG8_STAGE(PG8_SA(0, 1), cA + hstep, voffA);
        if (wr == 1) PG8_BAR;
        PG8_WAIT_V(2); PG8_BAR;
        PG8_STAGE(PG8_SB(1, 0), cB + kstep, voffB); PG8_STAGE(PG8_SA(1, 0), cA + kstep, voffA); PG8_STAGE(PG8_SB(1, 1), cB + hstep + kstep, voffB);
        PG8_WAIT_V(6); PG8_BAR;
    } else {
        PG8_STAGE(PG8_SB(0, 0), cB, voffB); PG8_STAGE(PG8_SA(0, 0), cA, voffA); PG8_STAGE(PG8_SB(0, 1), cB + hstep, voffB); PG8_STAGE(PG8_SA(0, 1), cA + hstep, voffA);
        if (wr == 1) PG8_BAR;
        PG8_WAIT_V(4); PG8_BAR;
        PG8_STAGE(PG8_SB(1, 0), cB + kstep, voffB); PG8_STAGE(PG8_SA(1, 0), cA + kstep, voffA); PG8_STAGE(PG8_SB(1, 1), cB + hstep + kstep, voffB);
        PG8_WAIT_V(6); PG8_BAR;
    }
    for (;;) {
        const bool has_next = S.next(ui + 1, nxt);
        const char* nA = has_next ? (const char*)g.A + (size_t)nxt.pm * tstep : cA; const char* nB = has_next ? (const char*)g.Bt + (size_t)nxt.pn * tstep : cB;
        for (int t = 0; t < nt; t += 2) {
            const bool last = (t == nt - 2);
            const char* a1 = cA + (size_t)(t + 1) * kstep;
            const char* a2 = last ? nA : cA + (size_t)(t + 2) * kstep; const char* b2 = last ? nB : cB + (size_t)(t + 2) * kstep;
            const char* a3 = a2 + kstep; const char* b3 = b2 + kstep;
            if (last && has_next) S.a_ready(nxt);
            if constexpr (SP2) {
            PG8_LDB(B0, 0, 0); PG8_LDB(B1, 0, 1); PG8_SCHED; PG8_LDA(At, 0, 0); PG8_STAGE(PG8_SA(1, 1), a1 + hstep, voffA);
            PG8_WAIT_V(8); PG8_WAIT_L(0); PG8_BAR; PG8_MMA(0, 0, At, B0); PG8_MMA(0, 1, At, B1); PG8_BAR; PG8_SCHED;
            PG8_LDA(At, 0, 1); PG8_STAGE(PG8_SB(0, 0), b2, voffB); PG8_STAGE(PG8_SB(0, 1), b2 + hstep, voffB); PG8_STAGE(PG8_SA(0, 0), a2, voffA);
            PG8_WAIT_V(8); PG8_WAIT_L(0); PG8_BAR; PG8_MMA(1, 0, At, B0); PG8_MMA(1, 1, At, B1); PG8_BAR; PG8_SCHED;
            PG8_LDB(B0, 1, 0); PG8_LDB(B1, 1, 1); PG8_SCHED; PG8_LDA(At, 1, 0); PG8_STAGE(PG8_SA(0, 1), a2 + hstep, voffA);
            PG8_WAIT_V(8); PG8_WAIT_L(0); PG8_BAR; PG8_MMA(0, 0, At, B0); PG8_MMA(0, 1, At, B1); PG8_BAR; PG8_SCHED;
            PG8_LDA(At, 1, 1); PG8_STAGE(PG8_SB(1, 0), b3, voffB); PG8_STAGE(PG8_SB(1, 1), b3 + hstep, voffB); PG8_STAGE(PG8_SA(1, 0), a3, voffA);
            PG8_WAIT_V(8); PG8_WAIT_L(0); PG8_BAR; PG8_MMA(1, 0, At, B0); PG8_MMA(1, 1, At, B1); PG8_BAR; PG8_SCHED;
            } else {
            PG8_LDB(B0, 0, 0); PG8_SCHED; PG8_LDA(At, 0, 0); PG8_STAGE(PG8_SA(1, 1), a1 + hstep, voffA);
            PG8_WAIT_L(8); PG8_BAR; PG8_WAIT_L(0); PG8_MMA(0, 0, At, B0); PG8_BAR; PG8_SCHED;
            PG8_LDB(B1, 0, 1); PG8_STAGE(PG8_SB(0, 0), b2, voffB);
            PG8_BAR; PG8_WAIT_L(0); PG8_MMA(0, 1, At, B1); PG8_BAR;
            PG8_LDA(At, 0, 1); PG8_STAGE(PG8_SA(0, 0), a2, voffA);
            PG8_BAR; PG8_WAIT_L(0); PG8_MMA(1, 0, At, B0); PG8_BAR; PG8_SCHED;
            PG8_STAGE(PG8_SB(0, 1), b2 + hstep, voffB);
            PG8_WAIT_V(6); PG8_BAR; PG8_MMA(1, 1, At, B1); PG8_BAR;
            PG8_LDB(B0, 1, 0); PG8_SCHED; PG8_LDA(At, 1, 0); PG8_STAGE(PG8_SA(0, 1), a2 + hstep, voffA);
            PG8_WAIT_L(8); PG8_BAR; PG8_WAIT_L(0); PG8_MMA(0, 0, At, B0); PG8_BAR; PG8_SCHED;
            PG8_LDB(B1, 1, 1); PG8_STAGE(PG8_SB(1, 0), b3, voffB);
            PG8_BAR; PG8_WAIT_L(0); PG8_MMA(0, 1, At, B1); PG8_BAR;
            PG8_LDA(At, 1, 1); PG8_STAGE(PG8_SA(1, 0), a3, voffA);
            PG8_BAR; PG8_WAIT_L(0); PG8_MMA(1, 0, At, B0); PG8_BAR; PG8_SCHED;
            PG8_STAGE(PG8_SB(1, 1), b3 + hstep, voffB);
            PG8_WAIT_V(6); PG8_BAR; PG8_MMA(1, 1, At, B1); PG8_BAR;
            }
        }
        if constexpr (ALIGN_EPI) { if (wr == 0) PG8_BAR; }
        if constexpr (!Epi::AFTER_DRAIN) { E(acc, cur, wr, wc, fr, fq); S.done(cur); }
        if (!has_next) break;
#pragma unroll
        for (int a = 0; a < 2; ++a)
#pragma unroll
            for (int b = 0; b < 2; ++b)
#pragma unroll
                for (int m = 0; m < 4; ++m)
#pragma unroll
                    for (int n = 0; n < 2; ++n) acc[a][b][m][n] = (f32x4){0.f, 0.f, 0.f, 0.f};
        cur = nxt; cA = nA; cB = nB; ++ui;
        if constexpr (ALIGN_EPI) { if (wr == 1) PG8_BAR; }
    }
    PG8_WAIT_V(0);
    if constexpr (!ALIGN_EPI) { if (wr == 0) PG8_BAR; }
    PG8_BAR;
    if constexpr (Epi::AFTER_DRAIN) { E.fused(acc, cur, wr, wc, fr, fq, lds, wid, lane); S.done(cur); }
#undef PG8_SA
#undef PG8_SB
#undef PG8_STAGE
#undef PG8_LDA
#undef PG8_LDB
#undef PG8_MMA
#undef PG8_WAIT_V
#undef PG8_WAIT_L
#undef PG8_BAR
#undef PG8_SCHED
}
}

#define XB_TMO      128
#define XB_XCNT(j)  (256  + 64 * (j))
#define XB_XSUB(j)  (1280 + 64 * (j))
#define XB_XGEN(j)  (2304 + 64 * (j))
#define XB_TOP      3328
#define XB_TOPGEN   3392
#define XCD_BAR_WORDS 3456
#define XB_SPIN_CAP (1u << 18)
#define LAS __attribute__((address_space(3)))
__device__ __forceinline__ unsigned xb_ld(unsigned* p)              { return __hip_atomic_load(p, __ATOMIC_RELAXED, __HIP_MEMORY_SCOPE_AGENT); }
__device__ __forceinline__ unsigned xb_add(unsigned* p, unsigned v) { return __hip_atomic_fetch_add(p, v, __ATOMIC_RELAXED, __HIP_MEMORY_SCOPE_AGENT); }
__device__ __forceinline__ unsigned xb_xcc_id() { return (unsigned)__builtin_amdgcn_s_getreg((3 << 11) | 20) & 0xFu; }
#define XB_SPIN(cond, bar) do { unsigned _sp = 0; while (cond) { __builtin_amdgcn_s_sleep(1); \
    if ((++_sp & 255u) == 0u) { if (xb_ld(&(bar)[XB_TMO])) break; if (_sp > XB_SPIN_CAP) { atomicAdd(&(bar)[XB_TMO], 1u); break; } } } } while (0)
struct XcdBarrier { unsigned* bar; unsigned x; volatile LAS unsigned* st; };
__device__ __forceinline__ XcdBarrier xcd_barrier_post(unsigned* bar, volatile LAS unsigned* st) {
    XcdBarrier b; b.bar = bar; b.x = xb_xcc_id(); b.st = st;
    if (threadIdx.x == 0) (void)xb_add(&bar[XB_XCNT(b.x)], 1u);
    return b;
}
__device__ __forceinline__ void xcd_barrier_complete(unsigned* bar, unsigned x, unsigned& nloc, unsigned& nx) {
    const unsigned G = gridDim.x * gridDim.y * gridDim.z;
    unsigned sum, cnt, mine, sp = 0u;
    for (;;) {
        sum = 0u; cnt = 0u; mine = 0u;
#pragma unroll
        for (unsigned j = 0; j < 16; ++j) { const unsigned c = xb_ld(&bar[XB_XCNT(j)]); sum += c; cnt += (c > 0u) ? 1u : 0u; mine = (j == x) ? c : mine; }
        if (sum == G) break;
        __builtin_amdgcn_s_sleep(1);
        if ((++sp & 255u) == 0u) { if (xb_ld(&bar[XB_TMO])) break; if (sp > XB_SPIN_CAP) { atomicAdd(&bar[XB_TMO], 1u); break; } }
    }
    nloc = mine > 0u ? mine : 1u; nx = cnt > 0u ? cnt : 1u;
}
__device__ __forceinline__ void xcd_barrier(const XcdBarrier& b) {
    asm volatile("s_waitcnt vmcnt(0)" ::: "memory");
    __syncthreads();
    if (threadIdx.x == 0) {
        unsigned* bar = b.bar;
        __builtin_amdgcn_s_waitcnt(0);
        unsigned nloc = b.st[0], nx = b.st[1];
        if (nloc == 0u) { xcd_barrier_complete(bar, b.x, nloc, nx); b.st[0] = nloc; b.st[1] = nx; }
        const unsigned old = xb_add(&bar[XB_XSUB(b.x)], 1u);
        const unsigned gen = old / nloc;
        if (old + 1u == (gen + 1u) * nloc) {
            __builtin_amdgcn_fence(__ATOMIC_RELEASE, "agent");
            asm volatile("s_waitcnt vmcnt(0)" ::: "memory");
            const unsigned og = xb_add(&bar[XB_TOP], 1u);
            const unsigned tg = og / nx;
            if (og + 1u == (tg + 1u) * nx) xb_add(&bar[XB_TOPGEN], 1u);
            else XB_SPIN(xb_ld(&bar[XB_TOPGEN]) == tg, bar);
            __builtin_amdgcn_fence(__ATOMIC_ACQUIRE, "agent");
            xb_add(&bar[XB_XGEN(b.x)], 1u);
            asm volatile("s_waitcnt vmcnt(0)" ::: "memory");
        } else {
            XB_SPIN(xb_ld(&bar[XB_XGEN(b.x)]) == gen, bar);
            __builtin_amdgcn_fence(__ATOMIC_ACQUIRE, "agent");
            asm volatile("s_waitcnt vmcnt(0)" ::: "memory");
        }
    }
    __syncthreads();
}

#ifndef PROBE
#define PROBE 0
#endif

typedef pg8::bf16_t bf16_t;
typedef pg8::bf16x8 bf16x8;
typedef pg8::f32x4 f32x4;
typedef pg8::u32x4 u32x4;
typedef unsigned u32x2 __attribute__((ext_vector_type(2)));
typedef float f32x2 __attribute__((ext_vector_type(2)));
using pg8::cvt_pk_bf16; using pg8::sigm;

constexpr int D = 1024, SEQ = 2048, NB = 8, M = 16384, WL = 1536;
static_assert(M == pg8::MROWS, "rows");
constexpr size_t MB = 1024 * 1024;
constexpr size_t WS_CTL = 0;
constexpr size_t WS_SSQ = 64 * 1024;
constexpr size_t WS_CARRY = WS_SSQ + 1 * MB;
constexpr size_t WS_WINE = WS_CARRY + 13 * MB;
constexpr size_t WS_WOUTE = WS_WINE + 20 * MB;
constexpr size_t WS_WINO = WS_WOUTE + 8 * MB;
constexpr size_t WS_WOUTO = WS_WINO + 12 * MB;
constexpr size_t WS_POOLT = WS_WOUTO + 6 * MB;
constexpr size_t WS_RGT = WS_POOLT + 1 * MB;
constexpr size_t WS_IGT = WS_RGT + 768 * 1024;
constexpr size_t WS_HB = WS_IGT + 768 * 1024;
constexpr size_t WS_ACT = WS_HB + 32 * MB;
constexpr size_t WS_END = WS_ACT + 128 * MB;
constexpr int RING_BYTES = 131072, CTL_OFF = RING_BYTES, LDS_BYTES = 147456;
constexpr unsigned CW_TMO2 = 15000;

struct Params {
    const float *x, *norm_even, *w_in_even, *conv_a_w, *conv_a_b, *ln_a_g, *ln_a_b, *pool_w, *pool_b, *pool_scale, *w_out_even,
                *norm_odd, *w_in_odd, *conv_c_w, *conv_c_b, *w_rg, *b_rg, *w_ig, *b_ig, *lru_lambda, *w_out_odd, *final_norm;
    float* out; unsigned char* ws;
};

__device__ __forceinline__ float wave_sum(float v) {
#pragma unroll
    for (int o = 1; o < 64; o <<= 1) v += __shfl_xor(v, o);
    return v;
}
__device__ __forceinline__ void lds_barrier() { asm volatile("s_waitcnt lgkmcnt(0)\n\ts_barrier" ::: "memory"); }
__device__ __forceinline__ float bf_lo(unsigned w) { return __uint_as_float(w << 16); }
__device__ __forceinline__ float bf_hi(unsigned w) { return __uint_as_float(w & 0xffff0000u); }

__device__ __forceinline__ void p0_item(const float* W, int K, int N, bf16_t* WT, const float* scale, int glu, float* scr, int item, int lane) {
    const int nblk = N / 32, kb = item / nblk, nb = item % nblk, k0 = 64 * kb, n0 = 32 * nb;
    int drow0 = n0;
    if (glu && n0 < 2048) { const int bj = n0 >> 10, cc = n0 & 1023; drow0 = 256 * (cc >> 7) + 128 * bj + (cc & 127); }
    float tv[32];
#pragma unroll
    for (int i = 0; i < 32; ++i) { const int kk = 2 * i + (lane >> 5); tv[i] = W[(size_t)(k0 + kk) * N + n0 + (lane & 31)]; }
    if (scale) {
#pragma unroll
        for (int i = 0; i < 32; ++i) tv[i] *= scale[k0 + 2 * i + (lane >> 5)]; }
#pragma unroll
    for (int i = 0; i < 32; ++i) scr[(2 * i + (lane >> 5)) * 33 + (lane & 31)] = tv[i];
    asm volatile("s_waitcnt lgkmcnt(0)" ::: "memory");
    const int c = lane & 7;
#pragma unroll
    for (int j = 0; j < 4; ++j) { const int n = (lane >> 3) + 8 * j; const float* s = scr + (8 * c) * 33 + n;
        u32x4 o; o.x = cvt_pk_bf16(s[0 * 33], s[1 * 33]); o.y = cvt_pk_bf16(s[2 * 33], s[3 * 33]); o.z = cvt_pk_bf16(s[4 * 33], s[5 * 33]); o.w = cvt_pk_bf16(s[6 * 33], s[7 * 33]);
        *(u32x4*)(WT + (size_t)(drow0 + n) * K + k0 + 8 * c) = o; }
    asm volatile("s_waitcnt lgkmcnt(0)" ::: "memory");
}
__device__ __forceinline__ void p0_prologue(const Params& p, unsigned char* lds, int wave, int lane) {
    float* scr = (float*)(lds + wave * 16384);
    const int gw = blockIdx.x * 8 + wave, NGW = gridDim.x * 8;
    unsigned char* ws = p.ws;
    constexpr int I_WINE = 16 * 160, I_WOUTE = 32 * 32, I_WINO = 16 * 96, I_WOUTO = 24 * 32, I_POOL = 4 * 8, I_G = 2 * 4;
    constexpr int NITEMS = 2 * (I_WINE + I_WOUTE + I_WINO + I_WOUTO) + 8 * I_POOL + 48 * I_G;
    for (int it = gw; it < NITEMS; it += NGW) {
        int r = it;
        if (r < 2 * I_WINE) { const int j = r / I_WINE; p0_item(p.w_in_even + (size_t)j * 1024 * 5120, 1024, 5120, (bf16_t*)(ws + WS_WINE) + (size_t)j * 5120 * 1024, p.norm_even + j * 1024, 1, scr, r % I_WINE, lane); continue; } r -= 2 * I_WINE;
        if (r < 2 * I_WOUTE) { const int j = r / I_WOUTE; p0_item(p.w_out_even + (size_t)j * 2048 * 1024, 2048, 1024, (bf16_t*)(ws + WS_WOUTE) + (size_t)j * 1024 * 2048, nullptr, 0, scr, r % I_WOUTE, lane); continue; } r -= 2 * I_WOUTE;
        if (r < 2 * I_WINO) { const int j = r / I_WINO; p0_item(p.w_in_odd + (size_t)j * 1024 * 3072, 1024, 3072, (bf16_t*)(ws + WS_WINO) + (size_t)j * 3072 * 1024, p.norm_odd + j * 1024, 0, scr, r % I_WINO, lane); continue; } r -= 2 * I_WINO;
        if (r < 2 * I_WOUTO) { const int j = r / I_WOUTO; p0_item(p.w_out_odd + (size_t)j * 1536 * 1024, 1536, 1024, (bf16_t*)(ws + WS_WOUTO) + (size_t)j * 1024 * 1536, nullptr, 0, scr, r % I_WOUTO, lane); continue; } r -= 2 * I_WOUTO;
        if (r < 8 * I_POOL) { const int j = r / I_POOL; p0_item(p.pool_w + (size_t)j * 65536, 256, 256, (bf16_t*)(ws + WS_POOLT) + (size_t)j * 65536, nullptr, 0, scr, r % I_POOL, lane); continue; } r -= 8 * I_POOL;
        if (r < 24 * I_G) { const int j = r / I_G; p0_item(p.w_rg + (size_t)j * 16384, 128, 128, (bf16_t*)(ws + WS_RGT) + (size_t)j * 16384, nullptr, 0, scr, r % I_G, lane); continue; } r -= 24 * I_G;
        { const int j = r / I_G; p0_item(p.w_ig + (size_t)j * 16384, 128, 128, (bf16_t*)(ws + WS_IGT) + (size_t)j * 16384, nullptr, 0, scr, r % I_G, lane); }
    }
    bf16_t* HB = (bf16_t*)(ws + WS_HB); float* ssq = (float*)(ws + WS_SSQ);
    for (int m0 = 4 * gw; m0 < M; m0 += 4 * NGW) {
        f32x4 v[4][4]; float s[4];
#pragma unroll
        for (int h = 0; h < 4; ++h) { const f32x4* xr = (const f32x4*)(p.x + (size_t)(m0 + h) * D) + lane;
#pragma unroll
            for (int j = 0; j < 4; ++j) v[h][j] = xr[64 * j]; }
#pragma unroll
        for (int h = 0; h < 4; ++h) { float a = 0.f;
#pragma unroll
            for (int j = 0; j < 4; ++j) a += (v[h][j][0] * v[h][j][0] + v[h][j][1] * v[h][j][1]) + (v[h][j][2] * v[h][j][2] + v[h][j][3] * v[h][j][3]);
            s[h] = a; }
#pragma unroll
        for (int o = 1; o < 64; o <<= 1) { s[0] += __shfl_xor(s[0], o); s[1] += __shfl_xor(s[1], o); s[2] += __shfl_xor(s[2], o); s[3] += __shfl_xor(s[3], o); }
#pragma unroll
        for (int h = 0; h < 4; ++h) { u32x2* o8 = (u32x2*)(HB + (size_t)(m0 + h) * D) + lane;
#pragma unroll
            for (int j = 0; j < 4; ++j) { u32x2 w; w.x = cvt_pk_bf16(v[h][j][0], v[h][j][1]); w.y = cvt_pk_bf16(v[h][j][2], v[h][j][3]); o8[64 * j] = w; }
            if (lane < 16) ssq[(size_t)lane * M + m0 + h] = (lane == 0) ? s[h] : 0.f; }
    }
    unsigned long long* cg = (unsigned long long*)(ws + WS_CARRY);
    for (size_t i = (size_t)blockIdx.x * 512 + threadIdx.x; i < (size_t)4 * 16 * 96 * 128; i += (size_t)gridDim.x * 512) cg[i] = 0ull;
}

#define CONV_TILE(k) ((int)(blockIdx.x & 7) * 128 + (int)(blockIdx.x >> 3) + 32 * (k))
__device__ __forceinline__ void e2_conv_phase(const Params& p, unsigned char* lds, int j, int tid, int wave, int lane, const bool dummy) {
    const bf16_t* U = (const bf16_t*)(p.ws + WS_ACT); const bf16_t* S = (const bf16_t*)(p.ws + WS_ACT + 64 * MB); bf16_t* W0 = dummy ? (bf16_t*)p.out - WS_HB / 2 : (bf16_t*)p.ws;
    const int c0 = 2 * tid;
    float* convo = (float*)lds;
    f32x2 w[31];
    { const float* cw = p.conv_a_w + (size_t)j * 31 * 1024 + c0;
#pragma unroll
      for (int k = 0; k < 31; ++k) w[k] = *(const f32x2*)(cw + k * 1024); }
    const f32x2 bias = *(const f32x2*)(p.conv_a_b + j * 1024 + c0);
    const float* lg = p.ln_a_g + j * 1024; const float* lb = p.ln_a_b + j * 1024;
#pragma unroll 1
    for (int k_ = 0; k_ < 4; ++k_) {
        const int tile = CONV_TILE(k_), b = tile >> 7, tt0 = (tile & 127) * 16;
        unsigned xr[46];
        { const __attribute__((address_space(1))) bf16_t* pr = (const __attribute__((address_space(1))) bf16_t*)U + ((long)b * SEQ + tt0 - 30) * 1024 + c0;
#pragma unroll
          for (int r = 0; r < 46; ++r) { const int t = tt0 - 30 + r; xr[r] = 0u; if (t >= 0) xr[r] = *(const __attribute__((address_space(1))) unsigned*)pr; pr += 1024; asm volatile("" : "+v"(pr)); } }
        const size_t row0 = (size_t)b * SEQ + tt0 + 2 * wave;
        u32x2 sw[2][4];
#pragma unroll
        for (int q = 0; q < 2; ++q)
#pragma unroll
            for (int jj = 0; jj < 4; ++jj) sw[q][jj] = *(const u32x2*)(S + (row0 + q) * 2048 + 4 * lane + 256 * jj);
#pragma unroll
        for (int i = 0; i < 16; ++i) { f32x2 a = bias;
#pragma unroll
            for (int k = 0; k < 31; ++k) a += w[k] * (f32x2){bf_lo(xr[i + k]), bf_hi(xr[i + k])};
            *(f32x2*)(convo + i * 1024 + c0) = a; }
        lds_barrier();
        f32x4 v[2][4]; float s[2], s2[2];
#pragma unroll
        for (int q = 0; q < 2; ++q) { s[q] = 0.f;
#pragma unroll
            for (int jj = 0; jj < 4; ++jj) { v[q][jj] = *(const f32x4*)(convo + (2 * wave + q) * 1024 + 4 * lane + 256 * jj); s[q] += (v[q][jj][0] + v[q][jj][1]) + (v[q][jj][2] + v[q][jj][3]); } }
#pragma unroll
        for (int o = 1; o < 64; o <<= 1) { s[0] += __shfl_xor(s[0], o); s[1] += __shfl_xor(s[1], o); }
#pragma unroll
        for (int q = 0; q < 2; ++q) { const float mean = s[q] * (1.0f / 1024.0f); s2[q] = 0.f;
#pragma unroll
            for (int jj = 0; jj < 4; ++jj) { v[q][jj] = v[q][jj] - mean; s2[q] += (v[q][jj][0] * v[q][jj][0] + v[q][jj][1] * v[q][jj][1]) + (v[q][jj][2] * v[q][jj][2] + v[q][jj][3] * v[q][jj][3]); } }
#pragma unroll
        for (int o = 1; o < 64; o <<= 1) { s2[0] += __shfl_xor(s2[0], o); s2[1] += __shfl_xor(s2[1], o); }
#pragma unroll
        for (int jj = 0; jj < 4; ++jj) { const int c = 4 * lane + 256 * jj; const f32x4 g = *(const f32x4*)(lg + c), be = *(const f32x4*)(lb + c);
#pragma unroll
            for (int q = 0; q < 2; ++q) { const float rstd = rsqrtf(s2[q] * (1.0f / 1024.0f) + 1e-5f); float o[4];
                const float sa[4] = {bf_lo(sw[q][jj].x), bf_hi(sw[q][jj].x), bf_lo(sw[q][jj].y), bf_hi(sw[q][jj].y)};
#pragma unroll
                for (int e = 0; e < 4; ++e) { const float y = v[q][jj][e] * rstd * g[e] + be[e]; o[e] = y * sigm(y) * sa[e]; }
                u32x2 ow; ow.x = cvt_pk_bf16(o[0], o[1]); ow.y = cvt_pk_bf16(o[2], o[3]);
                const size_t oo = dummy ? WS_HB / 2 + (row0 + q) * 1024 + c : (WS_ACT + 64 * MB) / 2 + (row0 + q) * 2048 + c; *(u32x2*)(W0 + oo) = ow; } }
        lds_barrier();
    }
}

template <int W>
__device__ __forceinline__ void pool_load(const bf16_t* BV, int b, int tt0, int g, int wave, int lane, bool live, u32x2 (&raw)[8 + W - 1]) {
    const bf16_t* src = BV + (size_t)b * SEQ * 1024 + 256 * g + 4 * lane;
#pragma unroll
    for (int r = 0; r < 8 + W - 1; ++r) { const int t = tt0 + 8 * wave - (W - 1) + r; raw[r] = (u32x2){0u, 0u}; if (live && t >= 0) raw[r] = *(const u32x2*)(src + (size_t)t * 1024); }
}
template <int W>
__device__ __forceinline__ void pool_rows(const u32x2 (&raw)[8 + W - 1], unsigned char* dl, int tt0, int wave, int lane) {
    f32x4 x[8 + W - 1];
#pragma unroll
    for (int r = 0; r < 8 + W - 1; ++r) x[r] = (f32x4){bf_lo(raw[r].x), bf_hi(raw[r].x), bf_lo(raw[r].y), bf_hi(raw[r].y)};
#pragma unroll
    for (int i = 0; i < 8; ++i) { const int t = tt0 + 8 * wave + i; f32x4 s = x[i];
#pragma unroll
        for (int jj = 1; jj < W; ++jj) s += x[i + jj];
        const float inv = 1.0f / (float)((t + 1) < W ? (t + 1) : W);
        const f32x4 d = s * inv - x[i + W - 1];
        u32x2 o; o.x = cvt_pk_bf16(d[0], d[1]); o.y = cvt_pk_bf16(d[2], d[3]);
        *(u32x2*)(dl + (8 * wave + i) * 528 + lane * 8) = o; }
}
template <int W>
__device__ __forceinline__ void e2_pool_phase(const Params& p, unsigned char* lds, int j, int g, int wave, int lane, const bool dummy) {
    const bf16_t* BV = (const bf16_t*)(p.ws + WS_ACT + 32 * MB); const bf16_t* S = (const bf16_t*)(p.ws + WS_ACT + 64 * MB); bf16_t* W0 = dummy ? (bf16_t*)p.out - WS_HB / 2 : (bf16_t*)p.ws;
    unsigned char* dl = lds;
    const int c = lane & 15, q = lane >> 4, e0 = 32 * wave;
    const bf16_t* Bt = (const bf16_t*)(p.ws + WS_POOLT) + (size_t)(j * 4 + g) * 65536;
    bf16x8 Bf[2][8];
#pragma unroll
    for (int nt = 0; nt < 2; ++nt)
#pragma unroll
        for (int ks = 0; ks < 8; ++ks) Bf[nt][ks] = *(const bf16x8*)(Bt + (size_t)(e0 + 16 * nt + c) * 256 + 32 * ks + 8 * q);
    f32x4 pb[2], ps[2];
#pragma unroll
    for (int nt = 0; nt < 2; ++nt) { const int ch = 256 * g + e0 + 16 * nt + 4 * q; pb[nt] = *(const f32x4*)(p.pool_b + j * 1024 + ch); ps[nt] = *(const f32x4*)(p.pool_scale + j * 1024 + ch); }
    const int b = blockIdx.x & 7, l2 = (int)(blockIdx.x >> 3) >> 2;
    constexpr bool PF = (W <= 8);
    u32x2 raw[PF ? 8 + W - 1 : 1];
    if constexpr (PF) pool_load<W>(BV, b, l2 * 64, g, wave, lane, true, raw);
#pragma unroll 1
    for (int k_ = 0; k_ < 4; ++k_) {
        const int tt0 = (l2 + 8 * k_) * 64;
        u32x2 rawN[PF ? 8 + W - 1 : 1], rawL[PF ? 1 : 8 + W - 1];
        if constexpr (PF) pool_load<W>(BV, b, (l2 + 8 * (k_ + 1)) * 64, g, wave, lane, k_ < 3, rawN);
        else pool_load<W>(BV, b, tt0, g, wave, lane, true, rawL);
        u32x2 sbw[4][2];
#pragma unroll
        for (int mt = 0; mt < 4; ++mt)
#pragma unroll
            for (int nt = 0; nt < 2; ++nt) sbw[mt][nt] = *(const u32x2*)(S + ((size_t)b * SEQ + tt0 + 16 * mt + c) * 2048 + 1024 + 256 * g + e0 + 16 * nt + 4 * q);
        if constexpr (PF) pool_rows<W>(raw, dl, tt0, wave, lane); else pool_rows<W>(rawL, dl, tt0, wave, lane);
        lds_barrier();
#pragma unroll
        for (int mt = 0; mt < 4; ++mt) {
            bf16x8 Af[8];
#pragma unroll
            for (int ks = 0; ks < 8; ++ks) Af[ks] = *(const bf16x8*)(dl + (16 * mt + c) * 528 + (32 * ks + 8 * q) * 2);
            f32x4 acc[2] = {(f32x4){0.f, 0.f, 0.f, 0.f}, (f32x4){0.f, 0.f, 0.f, 0.f}};
#pragma unroll
            for (int ks = 0; ks < 8; ++ks)
#pragma unroll
                for (int nt = 0; nt < 2; ++nt) acc[nt] = __builtin_amdgcn_mfma_f32_16x16x32_bf16(Bf[nt][ks], Af[ks], acc[nt], 0, 0, 0);
            const size_t row = (size_t)b * SEQ + tt0 + 16 * mt + c;
#pragma unroll
            for (int nt = 0; nt < 2; ++nt) { const int ch = 256 * g + e0 + 16 * nt + 4 * q; const u32x2 sw = sbw[mt][nt];
                const float sb[4] = {bf_lo(sw.x), bf_hi(sw.x), bf_lo(sw.y), bf_hi(sw.y)}; float o[4];
#pragma unroll
                for (int e = 0; e < 4; ++e) o[e] = (acc[nt][e] + pb[nt][e]) * ps[nt][e] * sb[e];
                u32x2 ow; ow.x = cvt_pk_bf16(o[0], o[1]); ow.y = cvt_pk_bf16(o[2], o[3]);
                const size_t oo = dummy ? WS_HB / 2 + row * 1024 + ch : (WS_ACT + 64 * MB) / 2 + row * 2048 + 1024 + ch; *(u32x2*)(W0 + oo) = ow; }
        }
        lds_barrier();
        if constexpr (PF) {
#pragma unroll
            for (int r = 0; r < 8 + W - 1; ++r) raw[r] = rawN[r]; }
    }
}

#define O2_TILE(k) ((int)(blockIdx.x & 7) * 192 + (int)(blockIdx.x >> 3) + 32 * (k))
#define O2_HEAD_CONSTS(IDX) do { const int id_ = (IDX), hd_ = (id_ % 192) % 12, jch_ = 16 * wave + c, ch_ = hd_ * 128 + jch_; \
        const bf16_t* RGT_ = (const bf16_t*)(p.ws + WS_RGT) + (size_t)(j * 12 + hd_) * 16384 + (size_t)jch_ * 128 + 8 * q; \
        const bf16_t* IGT_ = (const bf16_t*)(p.ws + WS_IGT) + (size_t)(j * 12 + hd_) * 16384 + (size_t)jch_ * 128 + 8 * q; \
        _Pragma("unroll") for (int ks = 0; ks < 4; ++ks) { Br[ks] = *(const bf16x8*)(RGT_ + 32 * ks); Bi[ks] = *(const bf16x8*)(IGT_ + 32 * ks); } \
        brg = p.b_rg[j * WL + ch_]; big = p.b_ig[j * WL + ch_]; lam = p.lru_lambda[j * WL + ch_]; \
        _Pragma("unroll") for (int k = 0; k < 4; ++k) cw[k] = *(const f32x4*)(p.conv_c_w + (size_t)(j * 4 + k) * WL + hd_ * 128 + c4); \
        cb = *(const f32x4*)(p.conv_c_b + j * WL + hd_ * 128 + c4); } while (0)
__device__ __forceinline__ void o2_phase(const Params& p, unsigned char* lds, int j, int tid, int wave, int lane, const bool dummy) {
    const bf16_t* XR = (const bf16_t*)(p.ws + WS_ACT); const bf16_t* SG = (const bf16_t*)(p.ws + WS_ACT + 48 * MB); bf16_t* W0 = dummy ? (bf16_t*)p.out - WS_HB / 2 : (bf16_t*)p.ws;
    float* XCF = (float*)lds;
    bf16_t* XCB = (bf16_t*)(lds + 128 * 528);
    const int c = lane & 15, q = lane >> 4;
    const int c4 = (lane & 31) * 4, tok0 = 16 * wave + 8 * (lane >> 5);
    const int oc4 = 16 * wave + (lane & 3) * 4, orow = lane >> 2;
    u32x2 xw[11], sgv[8];
    bf16x8 Br[4], Bi[4]; float brg, big, lam; f32x4 cw[4], cb;
    O2_HEAD_CONSTS(O2_TILE(0));
    { const int id = O2_TILE(0), b = id / 192, u_ = id % 192, chunk = u_ / 12, hd = u_ % 12, t0 = chunk * 128, chb = hd * 128;
      const bf16_t* src = XR + (size_t)b * SEQ * WL + chb + c4;
#pragma unroll
      for (int r = 0; r < 11; ++r) { const int t = t0 + tok0 - 3 + r; xw[r] = *(const u32x2*)(src + (size_t)(t < 0 ? 0 : t) * WL); }
      const size_t obase = ((size_t)b * SEQ + t0 + orow) * WL + chb + oc4;
#pragma unroll
      for (int k = 0; k < 8; ++k) sgv[k] = *(const u32x2*)(SG + obase + (size_t)(16 * k) * WL); }
#pragma unroll 1
    for (int k_ = 0; k_ < 6; ++k_) {
        const int id = O2_TILE(k_), b = id / 192, u_ = id % 192, chunk = u_ / 12, hd = u_ % 12, bh = b * 12 + hd, t0 = chunk * 128, chb = hd * 128;
        const int jch = 16 * wave + c, ch = chb + jch;
        {
            f32x4 xv[11];
#pragma unroll
            for (int r = 0; r < 11; ++r) { const bool in = (t0 + tok0 - 3 + r) >= 0; xv[r] = in ? (f32x4){bf_lo(xw[r].x), bf_hi(xw[r].x), bf_lo(xw[r].y), bf_hi(xw[r].y)} : (f32x4){0.f, 0.f, 0.f, 0.f}; }
#pragma unroll
            for (int i = 0; i < 8; ++i) { f32x4 v = cb;
#pragma unroll
                for (int k = 0; k < 4; ++k) v += cw[k] * xv[i + k];
                *(f32x4*)(XCF + (tok0 + i) * 132 + c4) = v;
                u32x2 o; o.x = cvt_pk_bf16(v[0], v[1]); o.y = cvt_pk_bf16(v[2], v[3]); *(u32x2*)(XCB + (tok0 + i) * 136 + c4) = o; }
        }
        lds_barrier();
        const float e_ = __expf(-lam); const float sp8 = 8.0f * (e_ < 0.0625f ? e_ * (1.0f - e_ * (0.5f - e_ * ((1.0f / 3.0f) - e_ * (0.25f - e_ * 0.2f)))) : __logf(1.0f + e_));
#pragma unroll
        for (int ks = 0; ks < 4; ++ks) asm volatile("" :: "v"(Br[ks]), "v"(Bi[ks]));
        asm volatile("" :: "v"(brg), "v"(big), "v"(sp8));
        { const int idN = O2_TILE(k_ < 5 ? k_ + 1 : k_), bN = idN / 192, uN = idN % 192, chunkN = uN / 12, hdN = uN % 12, t0N = chunkN * 128, chbN = hdN * 128;
          const bf16_t* src = XR + (size_t)bN * SEQ * WL + chbN + c4;
#pragma unroll
          for (int r = 0; r < 11; ++r) { const int t = t0N + tok0 - 3 + r; xw[r] = *(const u32x2*)(src + (size_t)(t < 0 ? 0 : t) * WL); }
        }
        float hz[8][4], pt[8][4];
        float Cz = 0.f, Pc = 1.f;
        if ((PROBE & 64) && dummy) {
#pragma unroll
            for (int s = 0; s < 8; ++s)
#pragma unroll
                for (int i = 0; i < 4; ++i) { hz[s][i] = 0.f; pt[s][i] = 1.f; } }
        else
#pragma unroll
        for (int s = 0; s < 8; ++s) {
            bf16x8 Af[4];
#pragma unroll
            for (int ks = 0; ks < 4; ++ks) Af[ks] = *(const bf16x8*)(XCB + (16 * s + c) * 136 + 32 * ks + 8 * q);
            f32x4 aR = (f32x4){0.f, 0.f, 0.f, 0.f}, aI = (f32x4){0.f, 0.f, 0.f, 0.f};
#pragma unroll
            for (int ks = 0; ks < 4; ++ks) { aR = __builtin_amdgcn_mfma_f32_16x16x32_bf16(Af[ks], Br[ks], aR, 0, 0, 0); aI = __builtin_amdgcn_mfma_f32_16x16x32_bf16(Af[ks], Bi[ks], aI, 0, 0, 0); }
            float ph = 0.f, pp = 1.f, hl[4], pl[4];
            float av[4], bv[4];
#pragma unroll
            for (int h2 = 0; h2 < 2; ++h2) {
                const f32x2 xc = (f32x2){XCF[(16 * s + 4 * q + 2 * h2) * 132 + jch], XCF[(16 * s + 4 * q + 2 * h2 + 1) * 132 + jch]};
                const f32x2 zr = ((f32x2){aR[2 * h2], aR[2 * h2 + 1]} + brg) * (-1.44269504f), zi = ((f32x2){aI[2 * h2], aI[2 * h2 + 1]} + big) * (-1.44269504f);
                f32x2 er, ei; er.x = __builtin_amdgcn_exp2f(zr.x); er.y = __builtin_amdgcn_exp2f(zr.y); ei.x = __builtin_amdgcn_exp2f(zi.x); ei.y = __builtin_amdgcn_exp2f(zi.y);
                const f32x2 dr = er + 1.0f, di = ei + 1.0f;
                f32x2 r, ig; r.x = __builtin_amdgcn_rcpf(dr.x); r.y = __builtin_amdgcn_rcpf(dr.y); ig.x = __builtin_amdgcn_rcpf(di.x); ig.y = __builtin_amdgcn_rcpf(di.y);
                const f32x2 x2 = r * (2.0f * sp8), la2 = r * (-1.44269504f * sp8);
                f32x2 a; a.x = __builtin_amdgcn_exp2f(la2.x); a.y = __builtin_amdgcn_exp2f(la2.y);
                const f32x2 ser = x2 * (1.0f - x2 * (0.5f - x2 * (1.0f / 6.0f))), dir = 1.0f - a * a;
                f32x2 om; om.x = x2.x < 0.015625f ? ser.x : dir.x; om.y = x2.y < 0.015625f ? ser.y : dir.y;
                f32x2 sq; sq.x = __builtin_amdgcn_sqrtf(om.x); sq.y = __builtin_amdgcn_sqrtf(om.y);
                const f32x2 bt = sq * (ig * xc);
                av[2 * h2] = a.x; av[2 * h2 + 1] = a.y; bv[2 * h2] = bt.x; bv[2 * h2 + 1] = bt.y;
            }
#pragma unroll
            for (int i = 0; i < 4; ++i) { ph = av[i] * ph + bv[i]; pp = pp * av[i]; hl[i] = ph; pl[i] = pp; }
            float P4 = pp, H4 = ph;
            { const float Pp = __shfl_up(P4, 16), Hp = __shfl_up(H4, 16); if (q >= 1) { H4 = P4 * Hp + H4; P4 = P4 * Pp; } }
            { const float Pp = __shfl_up(P4, 32), Hp = __shfl_up(H4, 32); if (q >= 2) { H4 = P4 * Hp + H4; P4 = P4 * Pp; } }
            float Pe = __shfl_up(P4, 16), He = __shfl_up(H4, 16); if (q == 0) { Pe = 1.f; He = 0.f; }
            const float Pt = __shfl(P4, 48 + c), Ht = __shfl(H4, 48 + c);
            const float Hs = Pe * Cz + He, Ps = Pe * Pc;
#pragma unroll
            for (int i = 0; i < 4; ++i) { hz[s][i] = hl[i] + pl[i] * Hs; pt[s][i] = pl[i] * Ps; }
            Cz = Pt * Cz + Ht; Pc = Pt * Pc;
        }
        unsigned long long* slots = (unsigned long long*)(p.ws + WS_CARRY) + ((size_t)((dummy ? j + 2 : j) * 16) * 96 + bh) * 128 + jch;
        if (chunk < 15 && q == 0)
            __hip_atomic_store(slots + (size_t)chunk * 96 * 128, ((unsigned long long)(__float_as_uint(Pc) | 0x80000000u) << 32) | (unsigned long long)__float_as_uint(Cz), __ATOMIC_RELAXED, __HIP_MEMORY_SCOPE_AGENT);
        float Hc = 0.f;
#pragma unroll
        for (int hb_ = 0; hb_ < 2; ++hb_) {
            if (chunk > 8 * hb_) {
                unsigned* tmo = (unsigned*)(p.ws + WS_CTL) + CW_TMO2; unsigned spins = 0u; unsigned long long va[8];
                for (;;) { bool ok = true;
#pragma unroll
                    for (int pc = 0; pc < 8; ++pc) if (8 * hb_ + pc < chunk) va[pc] = __hip_atomic_load(slots + (size_t)(8 * hb_ + pc) * 96 * 128, __ATOMIC_RELAXED, __HIP_MEMORY_SCOPE_AGENT);
#pragma unroll
                    for (int pc = 0; pc < 8; ++pc) if (8 * hb_ + pc < chunk) ok = ok && (((unsigned)(va[pc] >> 32) & 0x80000000u) != 0u);
                    if (__all(ok)) break;
                    __builtin_amdgcn_s_sleep(1);
                    if ((++spins & 255u) == 0u) { if (__hip_atomic_load(tmo, __ATOMIC_RELAXED, __HIP_MEMORY_SCOPE_AGENT) != 0u) break; if (spins > (1u << 19)) { __hip_atomic_store(tmo, 1u, __ATOMIC_RELAXED, __HIP_MEMORY_SCOPE_AGENT); break; } } }
#pragma unroll
                for (int pc = 0; pc < 8; ++pc) if (8 * hb_ + pc < chunk) Hc = __uint_as_float((unsigned)(va[pc] >> 32) & 0x7fffffffu) * Hc + __uint_as_float((unsigned)va[pc]);
            }
        }
        O2_HEAD_CONSTS(O2_TILE(k_ < 5 ? k_ + 1 : k_));
#pragma unroll
        for (int s = 0; s < 8; ++s)
#pragma unroll
            for (int i = 0; i < 4; ++i) XCF[(16 * s + 4 * q + i) * 132 + jch] = hz[s][i] + pt[s][i] * Hc;
        asm volatile("s_waitcnt lgkmcnt(0)" ::: "memory");
        const size_t obase = ((size_t)b * SEQ + t0 + orow) * WL + chb + oc4;
#pragma unroll
        for (int k = 0; k < 8; ++k) { const f32x4 h = *(const f32x4*)(XCF + (orow + 16 * k) * 132 + oc4); const u32x2 g = sgv[k];
            u32x2 ow; ow.x = cvt_pk_bf16(h[0] * bf_lo(g.x), h[1] * bf_hi(g.x)); ow.y = cvt_pk_bf16(h[2] * bf_lo(g.y), h[3] * bf_hi(g.y));
            const size_t oo = dummy ? WS_HB / 2 + ((size_t)b * SEQ + t0 + orow + 16 * k) * 1024 + ((chb + oc4) & 1023) : (WS_ACT + 48 * MB) / 2 + obase + (size_t)(16 * k) * WL;
            *(u32x2*)(W0 + oo) = ow; }
        lds_barrier();
        { const int idN = O2_TILE(k_ < 5 ? k_ + 1 : k_), bN = idN / 192, uN = idN % 192, chunkN = uN / 12, hdN = uN % 12, t0N = chunkN * 128, chbN = hdN * 128;
          const size_t obaseN = ((size_t)bN * SEQ + t0N + orow) * WL + chbN + oc4;
#pragma unroll
          for (int k = 0; k < 8; ++k) sgv[k] = *(const u32x2*)(SG + obaseN + (size_t)(16 * k) * WL); }
    }
}

typedef const __attribute__((address_space(4))) Params* KP;
#define GRID_BAR() do { KP qb_ = kp; asm volatile("" : "+s"(qb_)); XcdBarrier b_; b_.bar = (unsigned*)(qb_->ws + WS_CTL); b_.x = xb_xcc_id(); b_.st = (volatile LAS unsigned*)(ldsl + CTL_OFF); xcd_barrier(b_); } while (0)
#define PHASE_ARGS() KP qk_ = kp; asm volatile("" : "+s"(qk_)); Params pl; { const __attribute__((address_space(4))) unsigned long long* s_ = (const __attribute__((address_space(4))) unsigned long long*)qk_; char** d_ = (char**)&pl; _Pragma("unroll") for (int i_ = 0; i_ < 24; ++i_) d_[i_] = (char*)(__attribute__((address_space(1))) char*)s_[i_]; }     unsigned char* ws = pl.ws; \
    int wv = wave0_; asm volatile("" : "+s"(wv)); unsigned m1_ = ~0u; asm volatile("" : "+s"(m1_)); int ln = (int)__builtin_amdgcn_mbcnt_hi(m1_, __builtin_amdgcn_mbcnt_lo(m1_, 0u)); asm volatile("" : "+v"(ln)); const int tl = wv * 64 + ln; (void)tl; (void)ws
__global__ void __launch_bounds__(512, 2) trunk_fwd(Params p_unused) {
    extern __shared__ __attribute__((aligned(16))) unsigned char lds_raw[];
    LAS unsigned char* ldsl = (LAS unsigned char*)lds_raw;
    const KP kp = (KP)__builtin_amdgcn_kernarg_segment_ptr();
    const int G = gridDim.x;
    const int wave0_ = __builtin_amdgcn_readfirstlane((int)threadIdx.x >> 6);
    { PHASE_ARGS();
      if (tl < 16) ((LAS unsigned*)(ldsl + CTL_OFF))[tl] = 0u;
      __syncthreads();
      (void)xcd_barrier_post((unsigned*)(ws + WS_CTL), (volatile LAS unsigned*)(ldsl + CTL_OFF));
      _Pragma("unroll 1") for (int rep = 0; rep < ((PROBE & 8) ? 2 : 1); ++rep) p0_prologue(pl, lds_raw, wv, ln);
    }
    GRID_BAR();
    if (PROBE & 32) { _Pragma("unroll 1") for (int rep = 0; rep < 8; ++rep) GRID_BAR(); }
#pragma unroll 1
    for (int layer = 0; layer < 4; ++layer) {
        const int j = layer >> 1;
        if ((layer & 1) == 0) {
            { PHASE_ARGS(); float* ssq = (float*)(ws + WS_SSQ); bf16_t* HB = (bf16_t*)(ws + WS_HB);
              pg8::Gemm g{HB, (const bf16_t*)(ws + WS_WINE) + (size_t)j * 5120 * 1024, M, 5120, 1024}; pg8::StaticOrder S; S.init(M, 5120, G, (int)blockIdx.x);
              { const int pm_ = 8 * (int)(blockIdx.x & 7) + (int)((blockIdx.x >> 3) & 7);
                if (tl < 256) { const int row = 256 * pm_ + tl; float sq = 0.f;
                    _Pragma("unroll") for (int q_ = 0; q_ < 16; ++q_) sq += ssq[(size_t)q_ * M + row];
                    ((LAS float*)(ldsl + CTL_OFF + 1024))[tl] = rsqrtf(sq * (1.0f / 1024.0f) + 1e-6f); }
                __syncthreads(); }
              pg8::EpiE1 E{(const LAS float*)(ldsl + CTL_OFF + 1024), (bf16_t*)(ws + WS_ACT)};
              _Pragma("unroll 1") for (int rep = 0; rep < ((PROBE & 1) ? 2 : 1); ++rep) pg8::gemm_phase<pg8::EpiE1, pg8::StaticOrder, true, true>(ldsl, g, S, E, tl); }
            GRID_BAR();
            _Pragma("unroll 1") for (int rep = ((PROBE & 2) ? 0 : 1); rep < 2; ++rep) {
            #ifndef NO_CONV
            { PHASE_ARGS(); e2_conv_phase(pl, lds_raw, j, tl, wv, ln, (PROBE & 2) && rep == 0); }
#endif
#ifndef NO_POOL
            { PHASE_ARGS(); const int g_ = (int)(blockIdx.x >> 3) & 3; const bool dm = (PROBE & 2) && rep == 0;
              if (g_ == 0) e2_pool_phase<2>(pl, lds_raw, j, 0, wv, ln, dm); else if (g_ == 1) e2_pool_phase<4>(pl, lds_raw, j, 1, wv, ln, dm);
              else if (g_ == 2) e2_pool_phase<8>(pl, lds_raw, j, 2, wv, ln, dm); else e2_pool_phase<16>(pl, lds_raw, j, 3, wv, ln, dm); }
#endif
            }
            GRID_BAR();
            { PHASE_ARGS(); float* ssq = (float*)(ws + WS_SSQ); bf16_t* HB = (bf16_t*)(ws + WS_HB);
              pg8::Gemm g{(const bf16_t*)(ws + WS_ACT + 64 * MB), (const bf16_t*)(ws + WS_WOUTE) + (size_t)j * 1024 * 2048, M, 1024, 2048}; pg8::StaticOrder S; S.init(M, 1024, G, (int)blockIdx.x);
              pg8::EpiRes E{HB, ssq};
              _Pragma("unroll 1") for (int rep = 0; rep < (((PROBE & 16) && layer == 0) ? 2 : 1); ++rep) pg8::gemm_phase<pg8::EpiRes, pg8::StaticOrder, true, true>(ldsl, g, S, E, tl); }
            GRID_BAR();
        } else {
            { PHASE_ARGS(); float* ssq = (float*)(ws + WS_SSQ); bf16_t* HB = (bf16_t*)(ws + WS_HB);
              pg8::Gemm g{HB, (const bf16_t*)(ws + WS_WINO) + (size_t)j * 3072 * 1024, M, 3072, 1024}; pg8::StaticOrder S; S.init(M, 3072, G, (int)blockIdx.x);
              { const int pm_ = 8 * (int)(blockIdx.x & 7) + (int)((blockIdx.x >> 3) & 7);
                if (tl < 256) { const int row = 256 * pm_ + tl; float sq = 0.f;
                    _Pragma("unroll") for (int q_ = 0; q_ < 16; ++q_) sq += ssq[(size_t)q_ * M + row];
                    ((LAS float*)(ldsl + CTL_OFF + 1024))[tl] = rsqrtf(sq * (1.0f / 1024.0f) + 1e-6f); }
                __syncthreads(); }
              pg8::EpiO1 E{(const LAS float*)(ldsl + CTL_OFF + 1024), (bf16_t*)(ws + WS_ACT)};
              _Pragma("unroll 1") for (int rep = 0; rep < ((PROBE & 1) ? 2 : 1); ++rep) pg8::gemm_phase<pg8::EpiO1, pg8::StaticOrder, true, true>(ldsl, g, S, E, tl); }
            GRID_BAR();
            _Pragma("unroll 1") for (int rep = ((PROBE & 4) ? 0 : 1); rep < 2; ++rep)
#ifndef NO_O2
            { PHASE_ARGS(); o2_phase(pl, lds_raw, j, tl, wv, ln, (PROBE & 4) && rep == 0); }
#endif
            GRID_BAR();
            { PHASE_ARGS(); float* ssq = (float*)(ws + WS_SSQ); bf16_t* HB = (bf16_t*)(ws + WS_HB);
              pg8::Gemm g{(const bf16_t*)(ws + WS_ACT + 48 * MB), (const bf16_t*)(ws + WS_WOUTO) + (size_t)j * 1024 * 1536, M, 1024, 1536}; pg8::StaticOrder S; S.init(M, 1024, G, (int)blockIdx.x);
              if (layer == 3) {
                  pg8::EpiFinal E{HB, pl.out, pl.final_norm, ssq, (unsigned*)(ws + WS_CTL) + 4096, (unsigned*)(ws + WS_CTL) + CW_TMO2};
                  pg8::gemm_phase<pg8::EpiFinal, pg8::StaticOrder, false, true>(ldsl, g, S, E, tl);
              } else {
                  pg8::EpiRes E{HB, ssq};
                  pg8::gemm_phase<pg8::EpiRes, pg8::StaticOrder, true, true>(ldsl, g, S, E, tl); } }
            if (layer != 3) GRID_BAR();
        }
    }
}

extern "C" void kernel_launch(void* const* d_in, const int* in_sizes, int n_in, void* d_out, int out_size, void* d_ws, size_t ws_size, hipStream_t stream) {
    static int grid = 0;
    if (grid == 0) {
        if (n_in != 22 || out_size != M * D || ws_size < WS_END) { fprintf(stderr, "kernel_launch: unexpected shapes (n_in %d out %d ws %zu)\n", n_in, out_size, ws_size); grid = -1; return; }
        int dev = 0, cus = 0, per_cu = 0;
        hipGetDevice(&dev); hipDeviceGetAttribute(&cus, hipDeviceAttributeMultiprocessorCount, dev);
        hipFuncSetAttribute((const void*)trunk_fwd, hipFuncAttributeMaxDynamicSharedMemorySize, LDS_BYTES);
        hipOccupancyMaxActiveBlocksPerMultiprocessor(&per_cu, (const void*)trunk_fwd, 512, LDS_BYTES);
        (void)hipGetLastError();
        if (per_cu < 1) { fprintf(stderr, "kernel_launch: occupancy query says %d blocks per CU\n", per_cu); per_cu = 1; }
        grid = 256;
        if (cus < 256) { fprintf(stderr, "kernel_launch: %d CUs < 256\n", cus); grid = -1; return; }
    }
    if (grid < 0) return;
    hipMemsetAsync((char*)d_ws + WS_CTL, 0, 64 * 1024, stream);
    Params p{};
    const float** pp = (const float**)&p;
    for (int i = 0; i < 22; ++i) pp[i] = (const float*)d_in[i];
    p.out = (float*)d_out; p.ws = (unsigned char*)d_ws;
    void* args[] = {&p};
    hipError_t e = hipLaunchCooperativeKernel((const void*)trunk_fwd, dim3(grid), dim3(512), args, LDS_BYTES, stream);
    if (e != hipSuccess) fprintf(stderr, "kernel_launch: cooperative launch failed: %s (grid %d)\n", hipGetErrorString(e), grid);
}
```

```cpp
#include <hip/hip_runtime.h>
#include <cstdio>
#include <cstdint>
namespace pg8 {
#define PG8_LAS __attribute__((address_space(3)))
typedef unsigned short bf16_t;
typedef short bf16x8 __attribute__((ext_vector_type(8)));
typedef float f32x4 __attribute__((ext_vector_type(4)));
typedef unsigned u32x4 __attribute__((ext_vector_type(4)));
constexpr int BM = 256, BK = 64, HALF = 128, HTB = HALF * BK * 2  , STAGE_BYTES = 8 * HTB, NXCD = 8, WGM = 8;

__host__ __device__ __forceinline__ int lds_byte(int r, int c) { const int st = (r >> 4) * 2 + (c >> 5), rr = r & 15, cc = c & 31, ob = rr * 64 + cc * 2; return st * 1024 + (ob ^ (((ob >> 9) & 1) << 5)); }
__host__ __device__ __forceinline__ void stage_rc(int b, int& R, int& C) { const int st = b / 1024, sb = b % 1024, swz = sb ^ (((sb >> 9) & 1) << 5); R = (st >> 1) * 16 + swz / 64; C = (st & 1) * 32 + (swz % 64) / 2; }
__host__ __device__ __forceinline__ int perm32(int rho) { const int n = rho >> 4, i = rho & 15; return 8 * (i >> 2) + 4 * n + (i & 3); }

struct Unit { int pm, pn; };
struct Gemm { const bf16_t* A; const bf16_t* Bt; int M, N, K; };

struct StaticOrder {
    int nM, nN, nwg, G, c;
    __host__ __device__ void init(int M, int N, int G_, int c_) { nM = M / BM; nN = N / BM; nwg = nM * nN; G = G_; c = c_; }
    __host__ __device__ bool next(int i, Unit& u) const {
        const long L = (long)i * G + c; if (L >= nwg) return false;
        int wgid = (int)L; { const int q = nwg / NXCD, r = nwg % NXCD, xcd = wgid % NXCD, off = wgid / NXCD; wgid = (xcd < r ? xcd * (q + 1) : r * (q + 1) + (xcd - r) * q) + off; }
        const int nig = WGM * nN, gid = wgid / nig, fm = gid * WGM, gsz = (nM - fm) < WGM ? (nM - fm) : WGM;
        u.pm = fm + ((wgid % nig) % gsz); u.pn = (wgid % nig) / gsz; return true;
    }
    __device__ __forceinline__ void a_ready(const Unit&) const {}
    __device__ __forceinline__ void done(const Unit&) const {}
};
__device__ __forceinline__ unsigned cvt_pk_bf16(float lo, float hi) { unsigned r; asm volatile("v_cvt_pk_bf16_f32 %0, %1, %2" : "=v"(r) : "v"(lo), "v"(hi)); return r; }
__device__ __forceinline__ float sigm(float x) { return __builtin_amdgcn_rcpf(1.0f + __expf(-x)); }
constexpr int MROWS = 16384;
__device__ __forceinline__ f32x4 sigm4(f32x4 v) { const f32x4 z = v * (-1.44269504f); f32x4 e; e[0] = __builtin_amdgcn_exp2f(z[0]); e[1] = __builtin_amdgcn_exp2f(z[1]); e[2] = __builtin_amdgcn_exp2f(z[2]); e[3] = __builtin_amdgcn_exp2f(z[3]);
    const f32x4 d = e + 1.0f; f32x4 r; r[0] = __builtin_amdgcn_rcpf(d[0]); r[1] = __builtin_amdgcn_rcpf(d[1]); r[2] = __builtin_amdgcn_rcpf(d[2]); r[3] = __builtin_amdgcn_rcpf(d[3]); return r; }

struct EpiE1 {
    static constexpr bool PERM = true, AFTER_DRAIN = false;
    const PG8_LAS float* rsl; bf16_t* U;
    __device__ __forceinline__ void operator()(const f32x4 (&acc)[2][2][4][2], const Unit& u, int wr, int wc, int fr, int fq) const {
        const __amdgpu_buffer_rsrc_t rsrc = __builtin_amdgcn_make_buffer_rsrc((void*)U, 0, 0x08000000, 0x00020000);
        const int row0 = u.pm * BM + wr * 64 + fr, c8 = wc * 32 + 8 * fq;
        float rs[2][4];
#pragma unroll
        for (int ai = 0; ai < 2; ++ai)
#pragma unroll
            for (int m = 0; m < 4; ++m) rs[ai][m] = rsl[wr * 64 + ai * HALF + m * 16 + fr];
        if (u.pn < 8) {
#pragma unroll
            for (int ai = 0; ai < 2; ++ai)
#pragma unroll
                for (int m = 0; m < 4; ++m) { const float r = rs[ai][m]; bf16_t* rowp = U + (size_t)(row0 + ai * HALF + m * 16) * 1024 + u.pn * 128 + c8;
                    const f32x4 o0 = (acc[ai][0][m][0] * r) * sigm4(acc[ai][1][m][0] * r), o1 = (acc[ai][0][m][1] * r) * sigm4(acc[ai][1][m][1] * r);
                    u32x4 w; w.x = cvt_pk_bf16(o0[0], o0[1]); w.y = cvt_pk_bf16(o0[2], o0[3]); w.z = cvt_pk_bf16(o1[0], o1[1]); w.w = cvt_pk_bf16(o1[2], o1[3]);
                    __builtin_amdgcn_raw_buffer_store_b128(w, rsrc, (unsigned)((const char*)rowp - (const char*)U), 0, 16); }
        } else {
            const bool act = (u.pn < 12) || (u.pn >= 16); const bool isbv = !act;
            const int ldc = isbv ? 1024 : 2048, colt = (u.pn < 12) ? (u.pn - 8) * 256 : (isbv ? (u.pn - 12) * 256 : 1024 + (u.pn - 16) * 256);
            bf16_t* base = U + (isbv ? (size_t)16 * 1024 * 1024 : (size_t)32 * 1024 * 1024);
#pragma unroll
            for (int ai = 0; ai < 2; ++ai)
#pragma unroll
                for (int m = 0; m < 4; ++m) { const float r = rs[ai][m]; bf16_t* rowp = base + (size_t)(row0 + ai * HALF + m * 16) * ldc + colt + c8;
#pragma unroll
                    for (int bj = 0; bj < 2; ++bj) { f32x4 o0 = acc[ai][bj][m][0] * r, o1 = acc[ai][bj][m][1] * r;
                        if (act) { o0 = o0 * sigm4(o0); o1 = o1 * sigm4(o1); }
                        u32x4 w; w.x = cvt_pk_bf16(o0[0], o0[1]); w.y = cvt_pk_bf16(o0[2], o0[3]); w.z = cvt_pk_bf16(o1[0], o1[1]); w.w = cvt_pk_bf16(o1[2], o1[3]);
                        __builtin_amdgcn_raw_buffer_store_b128(w, rsrc, (unsigned)((const char*)(rowp + bj * HALF) - (const char*)U), 0, 16); } }
        }
    }
};
struct EpiO1 {
    static constexpr bool PERM = true, AFTER_DRAIN = false;
    const PG8_LAS float* rsl; bf16_t* XR;
    __device__ __forceinline__ void operator()(const f32x4 (&acc)[2][2][4][2], const Unit& u, int wr, int wc, int fr, int fq) const {
        const __amdgpu_buffer_rsrc_t rsrc = __builtin_amdgcn_make_buffer_rsrc((void*)XR, 0, 0x08000000, 0x00020000);
        const int row0 = u.pm * BM + wr * 64 + fr, c8 = wc * 32 + 8 * fq;
        float rs[2][4];
#pragma unroll
        for (int ai = 0; ai < 2; ++ai)
#pragma unroll
            for (int m = 0; m < 4; ++m) rs[ai][m] = rsl[wr * 64 + ai * HALF + m * 16 + fr];
        const bool act = u.pn >= 6;
        bf16_t* base = XR + (act ? (size_t)24 * 1024 * 1024 : (size_t)0); const int colt = (act ? u.pn - 6 : u.pn) * 256;
#pragma unroll
        for (int ai = 0; ai < 2; ++ai)
#pragma unroll
            for (int m = 0; m < 4; ++m) { const float r = rs[ai][m]; bf16_t* rowp = base + (size_t)(row0 + ai * HALF + m * 16) * 1536 + colt + c8;
#pragma unroll
                for (int bj = 0; bj < 2; ++bj) { f32x4 o0 = acc[ai][bj][m][0] * r, o1 = acc[ai][bj][m][1] * r;
                    if (act) { o0 = o0 * sigm4(o0); o1 = o1 * sigm4(o1); }
                    u32x4 w; w.x = cvt_pk_bf16(o0[0], o0[1]); w.y = cvt_pk_bf16(o0[2], o0[3]); w.z = cvt_pk_bf16(o1[0], o1[1]); w.w = cvt_pk_bf16(o1[2], o1[3]);
                    __builtin_amdgcn_raw_buffer_store_b128(w, rsrc, (unsigned)((const char*)(rowp + bj * HALF) - (const char*)XR), 0, 16); } }
    }
};
struct EpiRes {
    static constexpr bool PERM = true, AFTER_DRAIN = false;
    bf16_t* HB; float* ssq;
    __device__ __forceinline__ void operator()(const f32x4 (&acc)[2][2][4][2], const Unit& u, int wr, int wc, int fr, int fq) const {
        const int row0 = u.pm * BM + wr * 64 + fr, col0 = u.pn * BM + wc * 32 + 8 * fq;
#pragma unroll
        for (int ai = 0; ai < 2; ++ai)
#pragma unroll
            for (int m = 0; m < 4; ++m) { const int row = row0 + ai * HALF + m * 16; bf16_t* rowp = HB + (size_t)row * 1024 + col0; float s = 0.f;
#pragma unroll
                for (int bj = 0; bj < 2; ++bj) { const u32x4 b = *(const u32x4*)(rowp + bj * HALF); float o[8];
                    const float bb[8] = {__uint_as_float(b.x << 16), __uint_as_float(b.x & 0xffff0000u), __uint_as_float(b.y << 16), __uint_as_float(b.y & 0xffff0000u),
                                         __uint_as_float(b.z << 16), __uint_as_float(b.z & 0xffff0000u), __uint_as_float(b.w << 16), __uint_as_float(b.w & 0xffff0000u)};
#pragma unroll
                    for (int n = 0; n < 2; ++n)
#pragma unroll
                        for (int e = 0; e < 4; ++e) { o[4 * n + e] = bb[4 * n + e] + acc[ai][bj][m][n][e]; s += o[4 * n + e] * o[4 * n + e]; }
                    u32x4 w; w.x = cvt_pk_bf16(o[0], o[1]); w.y = cvt_pk_bf16(o[2], o[3]); w.z = cvt_pk_bf16(o[4], o[5]); w.w = cvt_pk_bf16(o[6], o[7]);
                    *(u32x4*)(rowp + bj * HALF) = w; }
                s += __shfl_xor(s, 16); s += __shfl_xor(s, 32);
                if (fq == 0) ssq[(size_t)(u.pn * 4 + wc) * MROWS + row] = s; }
    }
};
struct EpiFinal {
    static constexpr bool PERM = true, AFTER_DRAIN = true;
    const bf16_t* HB; float* out; const float* gain; float* xbuf; unsigned* cnt; unsigned* tmo;
    __device__ __forceinline__ void fused(f32x4 (&acc)[2][2][4][2], const Unit& u, int wr, int wc, int fr, int fq, PG8_LAS unsigned char* lds, int wid, int lane) const {
        PG8_LAS float* P = (PG8_LAS float*)lds;
        PG8_LAS float* R = (PG8_LAS float*)(lds + 4096);
        const int row0 = u.pm * BM + wr * 64 + fr, col0 = u.pn * BM + wc * 32 + 8 * fq;
#pragma unroll
        for (int ai = 0; ai < 2; ++ai)
#pragma unroll
            for (int m = 0; m < 4; ++m) { const int row = row0 + ai * HALF + m * 16; const bf16_t* rowp = HB + (size_t)row * 1024 + col0; float s = 0.f;
#pragma unroll
                for (int bj = 0; bj < 2; ++bj) { const u32x4 b = *(const u32x4*)(rowp + bj * HALF);
                    const f32x4 b0 = (f32x4){__uint_as_float(b.x << 16), __uint_as_float(b.x & 0xffff0000u), __uint_as_float(b.y << 16), __uint_as_float(b.y & 0xffff0000u)};
                    const f32x4 b1 = (f32x4){__uint_as_float(b.z << 16), __uint_as_float(b.z & 0xffff0000u), __uint_as_float(b.w << 16), __uint_as_float(b.w & 0xffff0000u)};
                    acc[ai][bj][m][0] += b0; acc[ai][bj][m][1] += b1;
                    const f32x4 q0 = acc[ai][bj][m][0] * acc[ai][bj][m][0], q1 = acc[ai][bj][m][1] * acc[ai][bj][m][1];
                    s += ((q0[0] + q0[1]) + (q0[2] + q0[3])) + ((q1[0] + q1[1]) + (q1[2] + q1[3])); }
                s += __shfl_xor(s, 16); s += __shfl_xor(s, 32);
                if (fq == 0) P[(wr * 64 + ai * HALF + m * 16 + fr) * 4 + wc] = s; }
        asm volatile("s_waitcnt lgkmcnt(0)" ::: "memory"); __builtin_amdgcn_s_barrier(); asm volatile("" ::: "memory");
        const int row = wid * 32 + (lane & 31);
        if (lane < 32) { const float t = (P[row * 4 + 0] + P[row * 4 + 1]) + (P[row * 4 + 2] + P[row * 4 + 3]);
            __hip_atomic_store(xbuf + (size_t)(u.pm * BM + row) * 4 + u.pn, t, __ATOMIC_RELAXED, __HIP_MEMORY_SCOPE_AGENT); }
        asm volatile("s_waitcnt vmcnt(0)" ::: "memory");
        if (lane == 0) __hip_atomic_fetch_add(cnt + 64 * u.pm, 1u, __ATOMIC_RELAXED, __HIP_MEMORY_SCOPE_AGENT);
        if (wid == 0) { unsigned spins = 0u;
            while ((unsigned)__builtin_amdgcn_readfirstlane(__hip_atomic_load(cnt + 64 * u.pm, __ATOMIC_RELAXED, __HIP_MEMORY_SCOPE_AGENT)) < 32u) {
                __builtin_amdgcn_s_sleep(1);
                if ((++spins & 255u) == 0u) { if (__hip_atomic_load(tmo, __ATOMIC_RELAXED, __HIP_MEMORY_SCOPE_AGENT) != 0u) break; if (spins > (1u << 19)) { if (lane == 0) __hip_atomic_store(tmo, 1u, __ATOMIC_RELAXED, __HIP_MEMORY_SCOPE_AGENT); break; } } }
            __builtin_amdgcn_fence(__ATOMIC_ACQUIRE, "agent"); }
        asm volatile("s_waitcnt vmcnt(0) lgkmcnt(0)" ::: "memory"); __builtin_amdgcn_s_barrier(); asm volatile("" ::: "memory");
        if (lane < 32) { const float* xs = xbuf + (size_t)(u.pm * BM + row) * 4; float t = 0.f;
#pragma unroll
            for (int k = 0; k < 4; ++k) t += __hip_atomic_load(xs + k, __ATOMIC_RELAXED, __HIP_MEMORY_SCOPE_AGENT);
            R[row] = rsqrtf(t * (1.0f / 1024.0f) + 1e-6f); }
        asm volatile("s_waitcnt lgkmcnt(0)" ::: "memory"); __builtin_amdgcn_s_barrier(); asm volatile("" ::: "memory");
        f32x4 gv[2][2];
#pragma unroll
        for (int bj = 0; bj < 2; ++bj)
#pragma unroll
            for (int n = 0; n < 2; ++n) gv[bj][n] = *(const f32x4*)(gain + col0 + bj * HALF + 4 * n);
#pragma unroll
        for (int ai = 0; ai < 2; ++ai)
#pragma unroll
            for (int m = 0; m < 4; ++m) { const int rl = wr * 64 + ai * HALF + m * 16 + fr; const float r = R[rl]; float* op = out + (size_t)(u.pm * BM + rl) * 1024 + col0;
#pragma unroll
                for (int bj = 0; bj < 2; ++bj)
#pragma unroll
                    for (int n = 0; n < 2; ++n) *(f32x4*)(op + bj * HALF + 4 * n) = acc[ai][bj][m][n] * r * gv[bj][n]; }
    }
};
template <class Epi, class Sched, bool ALIGN_EPI = false, bool SP2 = false>
__device__ __forceinline__ void gemm_phase(PG8_LAS unsigned char* lds, const Gemm g, const Sched& S, const Epi& E, const int tid_in) {
    int tid_ = tid_in; asm volatile("" : "+v"(tid_));
    const int tid = tid_, wid = __builtin_amdgcn_readfirstlane(tid >> 6), lane = tid & 63, wr = wid >> 2, wc = wid & 3, fr = lane & 15, fq = lane >> 4;
    const int K = g.K, nt = K / BK;
    unsigned voffA[2], voffB[2];
#pragma unroll
    for (int i = 0; i < 2; ++i) { int R, C; stage_rc(tid * 16 + i * 8192, R, C); const int Rb = Epi::PERM ? ((R & ~31) + perm32(R & 31)) : R;
        voffA[i] = (unsigned)(R * K + C) * 2u; voffB[i] = (unsigned)(Rb * K + C) * 2u; }
    const size_t kstep = (size_t)(BK * 2);
    const size_t hstep = (size_t)HALF * K * 2;
    const size_t tstep = 2 * hstep;
    const unsigned ldsw = (unsigned)wid * 1024u;
    const int aoff = lds_byte(wr * 64 + fr, fq * 8), boff = lds_byte(wc * 32 + fr, fq * 8);
#define PG8_SA(b, h) (((b) * 2 + (h)) * HTB)
#define PG8_SB(b, h) ((4 + (b) * 2 + (h)) * HTB)
#define PG8_STAGE(bufoff, gbase, voff) do { _Pragma("unroll") for (int _i = 0; _i < 2; ++_i) \
        __builtin_amdgcn_global_load_lds((const unsigned*)((const char*)(gbase) + (voff)[_i]), (PG8_LAS unsigned*)(lds + (bufoff) + ldsw + _i * 8192), 16, 0, 0); } while (0)
#define PG8_LDA(dst, b, h) do { _Pragma("unroll") for (int m = 0; m < 4; ++m) _Pragma("unroll") for (int k = 0; k < 2; ++k) dst[m][k] = *(const PG8_LAS bf16x8*)(lds + PG8_SA(b, h) + aoff + m * 2048 + k * 1024); } while (0)
#define PG8_LDB(dst, b, h) do { _Pragma("unroll") for (int n = 0; n < 2; ++n) _Pragma("unroll") for (int k = 0; k < 2; ++k) dst[n][k] = *(const PG8_LAS bf16x8*)(lds + PG8_SB(b, h) + boff + n * 2048 + k * 1024); } while (0)
#define PG8_MMA(ai, bj, At, Bt) do { __builtin_amdgcn_s_setprio(1); _Pragma("unroll") for (int m = 0; m < 4; ++m) _Pragma("unroll") for (int n = 0; n < 2; ++n) _Pragma("unroll") for (int k = 0; k < 2; ++k) \
        acc[ai][bj][m][n] = __builtin_amdgcn_mfma_f32_16x16x32_bf16(Bt[n][k], At[m][k], acc[ai][bj][m][n], 0, 0, 0); __builtin_amdgcn_s_setprio(0); } while (0)
#define PG8_WAIT_V(n) asm volatile("s_waitcnt vmcnt(" #n ")" ::: "memory")
#define PG8_WAIT_L(n) asm volatile("s_waitcnt lgkmcnt(" #n ")" ::: "memory")
#define PG8_BAR __builtin_amdgcn_s_barrier()
#define PG8_SCHED __builtin_amdgcn_sched_barrier(0)
    Unit cur, nxt; int ui = 0;
    if (!S.next(0, cur)) return;
    f32x4 acc[2][2][4][2];
#pragma unroll
    for (int a = 0; a < 2; ++a)
#pragma unroll
        for (int b = 0; b < 2; ++b)
#pragma unroll
            for (int m = 0; m < 4; ++m)
#pragma unroll
                for (int n = 0; n < 2; ++n) acc[a][b][m][n] = (f32x4){0.f, 0.f, 0.f, 0.f};
    bf16x8 At[4][2], B0[2][2], B1[2][2];
    const char* cA = (const char*)g.A + (size_t)cur.pm * tstep; const char* cB = (const char*)g.Bt + (size_t)cur.pn * tstep;
    S.a_ready(cur);
    if constexpr (SP2) {
        PG8_STAGE(PG8_SB(0, 0), cB, voffB); PG8_STAGE(PG8_SB(0, 1), cB + hstep, voffB); PG8_STAGE(PG8_SA(0, 0), cA, voffA); PG8_STAGE(PG8_SA(0, 1), cA + hstep, voffA);
        if (wr == 1) PG8_BAR;
        PG8_WAIT_V(2); PG8_BAR;
        PG8_STAGE(PG8_SB(1, 0), cB + kstep, voffB); PG8_STAGE(PG8_SA(1, 0), cA + kstep, voffA); PG8_STAGE(PG8_SB(1, 1), cB + hstep + kstep, voffB);
        PG8_WAIT_V(6); PG8_BAR;
    } else {
        PG8_STAGE(PG8_SB(0, 0), cB, voffB); PG8_STAGE(PG8_SA(0, 0), cA, voffA); PG8_STAGE(PG8_SB(0, 1), cB + hstep, voffB); PG8_STAGE(PG8_SA(0, 1), cA + hstep, voffA);
        if (wr == 1) PG8_BAR;
        PG8_WAIT_V(4); PG8_BAR;
        PG8_STAGE(PG8_SB(1, 0), cB + kstep, voffB); PG8_STAGE(PG8_SA(1, 0), cA + kstep, voffA); PG8_STAGE(PG8_SB(1, 1), cB + hstep + kstep, voffB);
        PG8_WAIT_V(6); PG8_BAR;
    }
    for (;;) {
        const bool has_next = S.next(ui + 1, nxt);
        const char* nA = has_next ? (const char*)g.A + (size_t)nxt.pm * tstep : cA; const char* nB = has_next ? (const char*)g.Bt + (size_t)nxt.pn * tstep : cB;
        for (int t = 0; t < nt; t += 2) {
            const bool last = (t == nt - 2);
            const char* a1 = cA + (size_t)(t + 1) * kstep;
            const char* a2 = last ? nA : cA + (size_t)(t + 2) * kstep; const char* b2 = last ? nB : cB + (size_t)(t + 2) * kstep;
            const char* a3 = a2 + kstep; const char* b3 = b2 + kstep;
            if (last && has_next) S.a_ready(nxt);
            if constexpr (SP2) {
            PG8_LDB(B0, 0, 0); PG8_LDB(B1, 0, 1); PG8_SCHED; PG8_LDA(At, 0, 0); PG8_STAGE(PG8_SA(1, 1), a1 + hstep, voffA);
            PG8_WAIT_V(8); PG8_WAIT_L(0); PG8_BAR; PG8_MMA(0, 0, At, B0); PG8_MMA(0, 1, At, B1); PG8_BAR; PG8_SCHED;
            PG8_LDA(At, 0, 1); PG8_STAGE(PG8_SB(0, 0), b2, voffB); PG8_STAGE(PG8_SB(0, 1), b2 + hstep, voffB); PG8_STAGE(PG8_SA(0, 0), a2, voffA);
            PG8_WAIT_V(8); PG8_WAIT_L(0); PG8_BAR; PG8_MMA(1, 0, At, B0); PG8_MMA(1, 1, At, B1); PG8_BAR; PG8_SCHED;
            PG8_LDB(B0, 1, 0); PG8_LDB(B1, 1, 1); PG8_SCHED; PG8_LDA(At, 1, 0); PG8_STAGE(PG8_SA(0, 1), a2 + hstep, voffA);
            PG8_WAIT_V(8); PG8_WAIT_L(0); PG8_BAR; PG8_MMA(0, 0, At, B0); PG8_MMA(0, 1, At, B1); PG8_BAR; PG8_SCHED;
            PG8_LDA(At, 1, 1); PG8_STAGE(PG8_SB(1, 0), b3, voffB); PG8_STAGE(PG8_SB(1, 1), b3 + hstep, voffB); PG8_STAGE(PG8_SA(1, 0), a3, voffA);
            PG8_WAIT_V(8); PG8_WAIT_L(0); PG8_BAR; PG8_MMA(1, 0, At, B0); PG8_MMA(1, 1, At, B1); PG8_BAR; PG8_SCHED;
            } else {
            PG8_LDB(B0, 0, 0); PG8_SCHED; PG8_LDA(At, 0, 0); PG8_STAGE(PG8_SA(1, 1), a1 + hstep, voffA);
            PG8_WAIT_L(8); PG8_BAR; PG8_WAIT_L(0); PG8_MMA(0, 0, At, B0); PG8_BAR; PG8_SCHED;
            PG8_LDB(B1, 0, 1); PG8_STAGE(PG8_SB(0, 0), b2, voffB);
            PG8_BAR; PG8_WAIT_L(0); PG8_MMA(0, 1, At, B1); PG8_BAR;
            PG8_LDA(At, 0, 1); PG8_STAGE(PG8_SA(0, 0), a2, voffA);
            PG8_BAR; PG8_WAIT_L(0); PG8_MMA(1, 0, At, B0); PG8_BAR; PG8_SCHED;
            PG8_STAGE(PG8_SB(0, 1), b2 + hstep, voffB);
            PG8_WAIT_V(6); PG8_BAR; PG8_MMA(1, 1, At, B1); PG8_BAR;
            PG8_LDB(B0, 1, 0); PG8_SCHED; PG8_LDA(At, 1, 0); PG8_STAGE(PG8_SA(0, 1), a2 + hstep, voffA);
            PG8_WAIT_L(8); PG8_BAR; PG8_WAIT_L(0); PG8_MMA(0, 0, At, B0); PG8_BAR; PG8_SCHED;
            PG8_LDB(B1, 1, 1); PG8_STAGE(PG8_SB(1, 0), b3, voffB);
            PG8_BAR; PG8_WAIT_L(0); PG8_MMA(0, 1, At, B1); PG8_BAR;
            PG8_LDA(At, 1, 1); PG8_STAGE(PG8_SA(1, 0), a3, voffA);
            PG8_BAR; PG8_WAIT_L(0); PG8_MMA(1, 0, At, B0); PG8_BAR; PG8_SCHED;
            PG8_STAGE(PG8_SB(1, 1), b3 + hstep, voffB);
            PG8_WAIT_V(6); PG8_BAR; PG8_MMA(1, 1, At, B1); PG8_BAR;
            }
        }
        if constexpr (ALIGN_EPI) { if (wr == 0) PG8_BAR; }
        if constexpr (!Epi::AFTER_DRAIN) { E(acc, cur, wr, wc, fr, fq); S.done(cur); }
        if (!has_next) break;
#pragma unroll
        for (int a = 0; a < 2; ++a)
#pragma unroll
            for (int b = 0; b < 2; ++b)
#pragma unroll
                for (int m = 0; m < 4; ++m)
#pragma unroll
                    for (int n = 0; n < 2; ++n) acc[a][b][m][n] = (f32x4){0.f, 0.f, 0.f, 0.f};
        cur = nxt; cA = nA; cB = nB; ++ui;
        if constexpr (ALIGN_EPI) { if (wr == 1) PG8_BAR; }
    }
    PG8_WAIT_V(0);
    if constexpr (!ALIGN_EPI) { if (wr == 0) PG8_BAR; }
    PG8_BAR;
    if constexpr (Epi::AFTER_DRAIN) { E.fused(acc, cur, wr, wc, fr, fq, lds, wid, lane); S.done(cur); }
#undef PG8_SA
#undef PG8_SB
#undef PG8_STAGE
#undef PG8_LDA
#undef PG8_LDB
#undef PG8_MMA
#undef PG8_WAIT_V
#undef PG8_WAIT_L
#undef PG8_BAR
#undef PG8_SCHED
}
}

#define XB_TMO      128
#define XB_XCNT(j)  (256  + 64 * (j))
#define XB_XSUB(j)  (1280 + 64 * (j))
#define XB_XGEN(j)  (2304 + 64 * (j))
#define XB_TOP      3328
#define XB_TOPGEN   3392
#define XCD_BAR_WORDS 3456
#define XB_SPIN_CAP (1u << 18)
#define LAS __attribute__((address_space(3)))
__device__ __forceinline__ unsigned xb_ld(unsigned* p)              { return __hip_atomic_load(p, __ATOMIC_RELAXED, __HIP_MEMORY_SCOPE_AGENT); }
__device__ __forceinline__ unsigned xb_add(unsigned* p, unsigned v) { return __hip_atomic_fetch_add(p, v, __ATOMIC_RELAXED, __HIP_MEMORY_SCOPE_AGENT); }
__device__ __forceinline__ unsigned xb_xcc_id() { return (unsigned)__builtin_amdgcn_s_getreg((3 << 11) | 20) & 0xFu; }
#define XB_SPIN(cond, bar) do { unsigned _sp = 0; while (cond) { __builtin_amdgcn_s_sleep(1); \
    if ((++_sp & 255u) == 0u) { if (xb_ld(&(bar)[XB_TMO])) break; if (_sp > XB_SPIN_CAP) { atomicAdd(&(bar)[XB_TMO], 1u); break; } } } } while (0)
struct XcdBarrier { unsigned* bar; unsigned x; volatile LAS unsigned* st; };
__device__ __forceinline__ XcdBarrier xcd_barrier_post(unsigned* bar, volatile LAS unsigned* st) {
    XcdBarrier b; b.bar = bar; b.x = xb_xcc_id(); b.st = st;
    if (threadIdx.x == 0) (void)xb_add(&bar[XB_XCNT(b.x)], 1u);
    return b;
}
__device__ __forceinline__ void xcd_barrier_complete(unsigned* bar, unsigned x, unsigned& nloc, unsigned& nx) {
    const unsigned G = gridDim.x * gridDim.y * gridDim.z;
    unsigned sum, cnt, mine, sp = 0u;
    for (;;) {
        sum = 0u; cnt = 0u; mine = 0u;
#pragma unroll
        for (unsigned j = 0; j < 16; ++j) { const unsigned c = xb_ld(&bar[XB_XCNT(j)]); sum += c; cnt += (c > 0u) ? 1u : 0u; mine = (j == x) ? c : mine; }
        if (sum == G) break;
        __builtin_amdgcn_s_sleep(1);
        if ((++sp & 255u) == 0u) { if (xb_ld(&bar[XB_TMO])) break; if (sp > XB_SPIN_CAP) { atomicAdd(&bar[XB_TMO], 1u); break; } }
    }
    nloc = mine > 0u ? mine : 1u; nx = cnt > 0u ? cnt : 1u;
}
__device__ __forceinline__ void xcd_barrier(const XcdBarrier& b) {
    asm volatile("s_waitcnt vmcnt(0)" ::: "memory");
    __syncthreads();
    if (threadIdx.x == 0) {
        unsigned* bar = b.bar;
        __builtin_amdgcn_s_waitcnt(0);
        unsigned nloc = b.st[0], nx = b.st[1];
        if (nloc == 0u) { xcd_barrier_complete(bar, b.x, nloc, nx); b.st[0] = nloc; b.st[1] = nx; }
        const unsigned old = xb_add(&bar[XB_XSUB(b.x)], 1u);
        const unsigned gen = old / nloc;
        if (old + 1u == (gen + 1u) * nloc) {
            __builtin_amdgcn_fence(__ATOMIC_RELEASE, "agent");
            asm volatile("s_waitcnt vmcnt(0)" ::: "memory");
            const unsigned og = xb_add(&bar[XB_TOP], 1u);
            const unsigned tg = og / nx;
            if (og + 1u == (tg + 1u) * nx) xb_add(&bar[XB_TOPGEN], 1u);
            else XB_SPIN(xb_ld(&bar[XB_TOPGEN]) == tg, bar);
            __builtin_amdgcn_fence(__ATOMIC_ACQUIRE, "agent");
            xb_add(&bar[XB_XGEN(b.x)], 1u);
            asm volatile("s_waitcnt vmcnt(0)" ::: "memory");
        } else {
            XB_SPIN(xb_ld(&bar[XB_XGEN(b.x)]) == gen, bar);
            __builtin_amdgcn_fence(__ATOMIC_ACQUIRE, "agent");
            asm volatile("s_waitcnt vmcnt(0)" ::: "memory");
        }
    }
    __syncthreads();
}

#ifndef PROBE
#define PROBE 0
#endif

typedef pg8::bf16_t bf16_t;
typedef pg8::bf16x8 bf16x8;
typedef pg8::f32x4 f32x4;
typedef pg8::u32x4 u32x4;
typedef unsigned u32x2 __attribute__((ext_vector_type(2)));
typedef float f32x2 __attribute__((ext_vector_type(2)));
using pg8::cvt_pk_bf16; using pg8::sigm;

constexpr int D = 1024, SEQ = 2048, NB = 8, M = 16384, WL = 1536;
static_assert(M == pg8::MROWS, "rows");
constexpr size_t MB = 1024 * 1024;
constexpr size_t WS_CTL = 0;
constexpr size_t WS_SSQ = 64 * 1024;
constexpr size_t WS_CARRY = WS_SSQ + 1 * MB;
constexpr size_t WS_WINE = WS_CARRY + 13 * MB;
constexpr size_t WS_WOUTE = WS_WINE + 20 * MB;
constexpr size_t WS_WINO = WS_WOUTE + 8 * MB;
constexpr size_t WS_WOUTO = WS_WINO + 12 * MB;
constexpr size_t WS_POOLT = WS_WOUTO + 6 * MB;
constexpr size_t WS_RGT = WS_POOLT + 1 * MB;
constexpr size_t WS_IGT = WS_RGT + 768 * 1024;
constexpr size_t WS_HB = WS_IGT + 768 * 1024;
constexpr size_t WS_ACT = WS_HB + 32 * MB;
constexpr size_t WS_END = WS_ACT + 128 * MB;
constexpr int RING_BYTES = 131072, CTL_OFF = RING_BYTES, LDS_BYTES = 147456;
constexpr unsigned CW_TMO2 = 15000;

struct Params {
    const float *x, *norm_even, *w_in_even, *conv_a_w, *conv_a_b, *ln_a_g, *ln_a_b, *pool_w, *pool_b, *pool_scale, *w_out_even,
                *norm_odd, *w_in_odd, *conv_c_w, *conv_c_b, *w_rg, *b_rg, *w_ig, *b_ig, *lru_lambda, *w_out_odd, *final_norm;
    float* out; unsigned char* ws;
};

__device__ __forceinline__ float wave_sum(float v) {
#pragma unroll
    for (int o = 1; o < 64; o <<= 1) v += __shfl_xor(v, o);
    return v;
}
__device__ __forceinline__ void lds_barrier() { asm volatile("s_waitcnt lgkmcnt(0)\n\ts_barrier" ::: "memory"); }
__device__ __forceinline__ float bf_lo(unsigned w) { return __uint_as_float(w << 16); }
__device__ __forceinline__ float bf_hi(unsigned w) { return __uint_as_float(w & 0xffff0000u); }

__device__ __forceinline__ void p0_item(const float* W, int K, int N, bf16_t* WT, const float* scale, int glu, float* scr, int item, int lane) {
    const int nblk = N / 32, kb = item / nblk, nb = item % nblk, k0 = 64 * kb, n0 = 32 * nb;
    int drow0 = n0;
    if (glu && n0 < 2048) { const int bj = n0 >> 10, cc = n0 & 1023; drow0 = 256 * (cc >> 7) + 128 * bj + (cc & 127); }
    float tv[32];
#pragma unroll
    for (int i = 0; i < 32; ++i) { const int kk = 2 * i + (lane >> 5); tv[i] = W[(size_t)(k0 + kk) * N + n0 + (lane & 31)]; }
    if (scale) {
#pragma unroll
        for (int i = 0; i < 32; ++i) tv[i] *= scale[k0 + 2 * i + (lane >> 5)]; }
#pragma unroll
    for (int i = 0; i < 32; ++i) scr[(2 * i + (lane >> 5)) * 33 + (lane & 31)] = tv[i];
    asm volatile("s_waitcnt lgkmcnt(0)" ::: "memory");
    const int c = lane & 7;
#pragma unroll
    for (int j = 0; j < 4; ++j) { const int n = (lane >> 3) + 8 * j; const float* s = scr + (8 * c) * 33 + n;
        u32x4 o; o.x = cvt_pk_bf16(s[0 * 33], s[1 * 33]); o.y = cvt_pk_bf16(s[2 * 33], s[3 * 33]); o.z = cvt_pk_bf16(s[4 * 33], s[5 * 33]); o.w = cvt_pk_bf16(s[6 * 33], s[7 * 33]);
        *(u32x4*)(WT + (size_t)(drow0 + n) * K + k0 + 8 * c) = o; }
    asm volatile("s_waitcnt lgkmcnt(0)" ::: "memory");
}
__device__ __forceinline__ void p0_prologue(const Params& p, unsigned char* lds, int wave, int lane) {
    float* scr = (float*)(lds + wave * 16384);
    const int gw = blockIdx.x * 8 + wave, NGW = gridDim.x * 8;
    unsigned char* ws = p.ws;
    constexpr int I_WINE = 16 * 160, I_WOUTE = 32 * 32, I_WINO = 16 * 96, I_WOUTO = 24 * 32, I_POOL = 4 * 8, I_G = 2 * 4;
    constexpr int NITEMS = 2 * (I_WINE + I_WOUTE + I_WINO + I_WOUTO) + 8 * I_POOL + 48 * I_G;
    for (int it = gw; it < NITEMS; it += NGW) {
        int r = it;
        if (r < 2 * I_WINE) { const int j = r / I_WINE; p0_item(p.w_in_even + (size_t)j * 1024 * 5120, 1024, 5120, (bf16_t*)(ws + WS_WINE) + (size_t)j * 5120 * 1024, p.norm_even + j * 1024, 1, scr, r % I_WINE, lane); continue; } r -= 2 * I_WINE;
        if (r < 2 * I_WOUTE) { const int j = r / I_WOUTE; p0_item(p.w_out_even + (size_t)j * 2048 * 1024, 2048, 1024, (bf16_t*)(ws + WS_WOUTE) + (size_t)j * 1024 * 2048, nullptr, 0, scr, r % I_WOUTE, lane); continue; } r -= 2 * I_WOUTE;
        if (r < 2 * I_WINO) { const int j = r / I_WINO; p0_item(p.w_in_odd + (size_t)j * 1024 * 3072, 1024, 3072, (bf16_t*)(ws + WS_WINO) + (size_t)j * 3072 * 1024, p.norm_odd + j * 1024, 0, scr, r % I_WINO, lane); continue; } r -= 2 * I_WINO;
        if (r < 2 * I_WOUTO) { const int j = r / I_WOUTO; p0_item(p.w_out_odd + (size_t)j * 1536 * 1024, 1536, 1024, (bf16_t*)(ws + WS_WOUTO) + (size_t)j * 1024 * 1536, nullptr, 0, scr, r % I_WOUTO, lane); continue; } r -= 2 * I_WOUTO;
        if (r < 8 * I_POOL) { const int j = r / I_POOL; p0_item(p.pool_w + (size_t)j * 65536, 256, 256, (bf16_t*)(ws + WS_POOLT) + (size_t)j * 65536, nullptr, 0, scr, r % I_POOL, lane); continue; } r -= 8 * I_POOL;
        if (r < 24 * I_G) { const int j = r / I_G; p0_item(p.w_rg + (size_t)j * 16384, 128, 128, (bf16_t*)(ws + WS_RGT) + (size_t)j * 16384, nullptr, 0, scr, r % I_G, lane); continue; } r -= 24 * I_G;
        { const int j = r / I_G; p0_item(p.w_ig + (size_t)j * 16384, 128, 128, (bf16_t*)(ws + WS_IGT) + (size_t)j * 16384, nullptr, 0, scr, r % I_G, lane); }
    }
    bf16_t* HB = (bf16_t*)(ws + WS_HB); float* ssq = (float*)(ws + WS_SSQ);
    for (int m0 = 4 * gw; m0 < M; m0 += 4 * NGW) {
        f32x4 v[4][4]; float s[4];
#pragma unroll
        for (int h = 0; h < 4; ++h) { const f32x4* xr = (const f32x4*)(p.x + (size_t)(m0 + h) * D) + lane;
#pragma unroll
            for (int j = 0; j < 4; ++j) v[h][j] = xr[64 * j]; }
#pragma unroll
        for (int h = 0; h < 4; ++h) { float a = 0.f;
#pragma unroll
            for (int j = 0; j < 4; ++j) a += (v[h][j][0] * v[h][j][0] + v[h][j][1] * v[h][j][1]) + (v[h][j][2] * v[h][j][2] + v[h][j][3] * v[h][j][3]);
            s[h] = a; }
#pragma unroll
        for (int o = 1; o < 64; o <<= 1) { s[0] += __shfl_xor(s[0], o); s[1] += __shfl_xor(s[1], o); s[2] += __shfl_xor(s[2], o); s[3] += __shfl_xor(s[3], o); }
#pragma unroll
        for (int h = 0; h < 4; ++h) { u32x2* o8 = (u32x2*)(HB + (size_t)(m0 + h) * D) + lane;
#pragma unroll
            for (int j = 0; j < 4; ++j) { u32x2 w; w.x = cvt_pk_bf16(v[h][j][0], v[h][j][1]); w.y = cvt_pk_bf16(v[h][j][2], v[h][j][3]); o8[64 * j] = w; }
            if (lane < 16) ssq[(size_t)lane * M + m0 + h] = (lane == 0) ? s[h] : 0.f; }
    }
    unsigned long long* cg = (unsigned long long*)(ws + WS_CARRY);
    for (size_t i = (size_t)blockIdx.x * 512 + threadIdx.x; i < (size_t)4 * 16 * 96 * 128; i += (size_t)gridDim.x * 512) cg[i] = 0ull;
}

#define CONV_TILE(k) ((int)(blockIdx.x & 7) * 128 + (int)(blockIdx.x >> 3) + 32 * (k))
__device__ __forceinline__ void e2_conv_phase(const Params& p, unsigned char* lds, int j, int tid, int wave, int lane, const bool dummy) {
    const bf16_t* U = (const bf16_t*)(p.ws + WS_ACT); const bf16_t* S = (const bf16_t*)(p.ws + WS_ACT + 64 * MB); bf16_t* W0 = dummy ? (bf16_t*)p.out - WS_HB / 2 : (bf16_t*)p.ws;
    const int c0 = 2 * tid;
    float* convo = (float*)lds;
    f32x2 w[31];
    { const float* cw = p.conv_a_w + (size_t)j * 31 * 1024 + c0;
#pragma unroll
      for (int k = 0; k < 31; ++k) w[k] = *(const f32x2*)(cw + k * 1024); }
    const f32x2 bias = *(const f32x2*)(p.conv_a_b + j * 1024 + c0);
    const float* lg = p.ln_a_g + j * 1024; const float* lb = p.ln_a_b + j * 1024;
#pragma unroll 1
    for (int k_ = 0; k_ < 4; ++k_) {
        const int tile = CONV_TILE(k_), b = tile >> 7, tt0 = (tile & 127) * 16;
        unsigned xr[46];
        { const __attribute__((address_space(1))) bf16_t* pr = (const __attribute__((address_space(1))) bf16_t*)U + ((long)b * SEQ + tt0 - 30) * 1024 + c0;
#pragma unroll
          for (int r = 0; r < 46; ++r) { const int t = tt0 - 30 + r; xr[r] = 0u; if (t >= 0) xr[r] = *(const __attribute__((address_space(1))) unsigned*)pr; pr += 1024; asm volatile("" : "+v"(pr)); } }
        const size_t row0 = (size_t)b * SEQ + tt0 + 2 * wave;
        u32x2 sw[2][4];
#pragma unroll
        for (int q = 0; q < 2; ++q)
#pragma unroll
            for (int jj = 0; jj < 4; ++jj) sw[q][jj] = *(const u32x2*)(S + (row0 + q) * 2048 + 4 * lane + 256 * jj);
#pragma unroll
        for (int i = 0; i < 16; ++i) { f32x2 a = bias;
#pragma unroll
            for (int k = 0; k < 31; ++k) a += w[k] * (f32x2){bf_lo(xr[i + k]), bf_hi(xr[i + k])};
            *(f32x2*)(convo + i * 1024 + c0) = a; }
        lds_barrier();
        f32x4 v[2][4]; float s[2], s2[2];
#pragma unroll
        for (int q = 0; q < 2; ++q) { s[q] = 0.f;
#pragma unroll
            for (int jj = 0; jj < 4; ++jj) { v[q][jj] = *(const f32x4*)(convo + (2 * wave + q) * 1024 + 4 * lane + 256 * jj); s[q] += (v[q][jj][0] + v[q][jj][1]) + (v[q][jj][2] + v[q][jj][3]); } }
#pragma unroll
        for (int o = 1; o < 64; o <<= 1) { s[0] += __shfl_xor(s[0], o); s[1] += __shfl_xor(s[1], o); }
#pragma unroll
        for (int q = 0; q < 2; ++q) { const float mean = s[q] * (1.0f / 1024.0f); s2[q] = 0.f;
#pragma unroll
            for (int jj = 0; jj < 4; ++jj) { v[q][jj] = v[q][jj] - mean; s2[q] += (v[q][jj][0] * v[q][jj][0] + v[q][jj][1] * v[q][jj][1]) + (v[q][jj][2] * v[q][jj][2] + v[q][jj][3] * v[q][jj][3]); } }
#pragma unroll
        for (int o = 1; o < 64; o <<= 1) { s2[0] += __shfl_xor(s2[0], o); s2[1] += __shfl_xor(s2[1], o); }
#pragma unroll
        for (int jj = 0; jj < 4; ++jj) { const int c = 4 * lane + 256 * jj; const f32x4 g = *(const f32x4*)(lg + c), be = *(const f32x4*)(lb + c);
#pragma unroll
            for (int q = 0; q < 2; ++q) { const float rstd = rsqrtf(s2[q] * (1.0f / 1024.0f) + 1e-5f); float o[4];
                const float sa[4] = {bf_lo(sw[q][jj].x), bf_hi(sw[q][jj].x), bf_lo(sw[q][jj].y), bf_hi(sw[q][jj].y)};
#pragma unroll
                for (int e = 0; e < 4; ++e) { const float y = v[q][jj][e] * rstd * g[e] + be[e]; o[e] = y * sigm(y) * sa[e]; }
                u32x2 ow; ow.x = cvt_pk_bf16(o[0], o[1]); ow.y = cvt_pk_bf16(o[2], o[3]);
                const size_t oo = dummy ? WS_HB / 2 + (row0 + q) * 1024 + c : (WS_ACT + 64 * MB) / 2 + (row0 + q) * 2048 + c; *(u32x2*)(W0 + oo) = ow; } }
        lds_barrier();
    }
}

template <int W>
__device__ __forceinline__ void pool_load(const bf16_t* BV, int b, int tt0, int g, int wave, int lane, bool live, u32x2 (&raw)[8 + W - 1]) {
    const bf16_t* src = BV + (size_t)b * SEQ * 1024 + 256 * g + 4 * lane;
#pragma unroll
    for (int r = 0; r < 8 + W - 1; ++r) { const int t = tt0 + 8 * wave - (W - 1) + r; raw[r] = (u32x2){0u, 0u}; if (live && t >= 0) raw[r] = *(const u32x2*)(src + (size_t)t * 1024); }
}
template <int W>
__device__ __forceinline__ void pool_rows(const u32x2 (&raw)[8 + W - 1], unsigned char* dl, int tt0, int wave, int lane) {
    f32x4 x[8 + W - 1];
#pragma unroll
    for (int r = 0; r < 8 + W - 1; ++r) x[r] = (f32x4){bf_lo(raw[r].x), bf_hi(raw[r].x), bf_lo(raw[r].y), bf_hi(raw[r].y)};
#pragma unroll
    for (int i = 0; i < 8; ++i) { const int t = tt0 + 8 * wave + i; f32x4 s = x[i];
#pragma unroll
        for (int jj = 1; jj < W; ++jj) s += x[i + jj];
        const float inv = 1.0f / (float)((t + 1) < W ? (t + 1) : W);
        const f32x4 d = s * inv - x[i + W - 1];
        u32x2 o; o.x = cvt_pk_bf16(d[0], d[1]); o.y = cvt_pk_bf16(d[2], d[3]);
        *(u32x2*)(dl + (8 * wave + i) * 528 + lane * 8) = o; }
}
template <int W>
__device__ __forceinline__ void e2_pool_phase(const Params& p, unsigned char* lds, int j, int g, int wave, int lane, const bool dummy) {
    const bf16_t* BV = (const bf16_t*)(p.ws + WS_ACT + 32 * MB); const bf16_t* S = (const bf16_t*)(p.ws + WS_ACT + 64 * MB); bf16_t* W0 = dummy ? (bf16_t*)p.out - WS_HB / 2 : (bf16_t*)p.ws;
    unsigned char* dl = lds;
    const int c = lane & 15, q = lane >> 4, e0 = 32 * wave;
    const bf16_t* Bt = (const bf16_t*)(p.ws + WS_POOLT) + (size_t)(j * 4 + g) * 65536;
    bf16x8 Bf[2][8];
#pragma unroll
    for (int nt = 0; nt < 2; ++nt)
#pragma unroll
        for (int ks = 0; ks < 8; ++ks) Bf[nt][ks] = *(const bf16x8*)(Bt + (size_t)(e0 + 16 * nt + c) * 256 + 32 * ks + 8 * q);
    f32x4 pb[2], ps[2];
#pragma unroll
    for (int nt = 0; nt < 2; ++nt) { const int ch = 256 * g + e0 + 16 * nt + 4 * q; pb[nt] = *(const f32x4*)(p.pool_b + j * 1024 + ch); ps[nt] = *(const f32x4*)(p.pool_scale + j * 1024 + ch); }
    const int b = blockIdx.x & 7, l2 = (int)(blockIdx.x >> 3) >> 2;
    constexpr bool PF = (W <= 8);
    u32x2 raw[PF ? 8 + W - 1 : 1];
    if constexpr (PF) pool_load<W>(BV, b, l2 * 64, g, wave, lane, true, raw);
#pragma unroll 1
    for (int k_ = 0; k_ < 4; ++k_) {
        const int tt0 = (l2 + 8 * k_) * 64;
        u32x2 rawN[PF ? 8 + W - 1 : 1], rawL[PF ? 1 : 8 + W - 1];
        if constexpr (PF) pool_load<W>(BV, b, (l2 + 8 * (k_ + 1)) * 64, g, wave, lane, k_ < 3, rawN);
        else pool_load<W>(BV, b, tt0, g, wave, lane, true, rawL);
        u32x2 sbw[4][2];
#pragma unroll
        for (int mt = 0; mt < 4; ++mt)
#pragma unroll
            for (int nt = 0; nt < 2; ++nt) sbw[mt][nt] = *(const u32x2*)(S + ((size_t)b * SEQ + tt0 + 16 * mt + c) * 2048 + 1024 + 256 * g + e0 + 16 * nt + 4 * q);
        if constexpr (PF) pool_rows<W>(raw, dl, tt0, wave, lane); else pool_rows<W>(rawL, dl, tt0, wave, lane);
        lds_barrier();
#pragma unroll
        for (int mt = 0; mt < 4; ++mt) {
            bf16x8 Af[8];
#pragma unroll
            for (int ks = 0; ks < 8; ++ks) Af[ks] = *(const bf16x8*)(dl + (16 * mt + c) * 528 + (32 * ks + 8 * q) * 2);
            f32x4 acc[2] = {(f32x4){0.f, 0.f, 0.f, 0.f}, (f32x4){0.f, 0.f, 0.f, 0.f}};
#pragma unroll
            for (int ks = 0; ks < 8; ++ks)
#pragma unroll
                for (int nt = 0; nt < 2; ++nt) acc[nt] = __builtin_amdgcn_mfma_f32_16x16x32_bf16(Bf[nt][ks], Af[ks], acc[nt], 0, 0, 0);
            const size_t row = (size_t)b * SEQ + tt0 + 16 * mt + c;
#pragma unroll
            for (int nt = 0; nt < 2; ++nt) { const int ch = 256 * g + e0 + 16 * nt + 4 * q; const u32x2 sw = sbw[mt][nt];
                const float sb[4] = {bf_lo(sw.x), bf_hi(sw.x), bf_lo(sw.y), bf_hi(sw.y)}; float o[4];
#pragma unroll
                for (int e = 0; e < 4; ++e) o[e] = (acc[nt][e] + pb[nt][e]) * ps[nt][e] * sb[e];
                u32x2 ow; ow.x = cvt_pk_bf16(o[0], o[1]); ow.y = cvt_pk_bf16(o[2], o[3]);
                const size_t oo = dummy ? WS_HB / 2 + row * 1024 + ch : (WS_ACT + 64 * MB) / 2 + row * 2048 + 1024 + ch; *(u32x2*)(W0 + oo) = ow; }
        }
        lds_barrier();
        if constexpr (PF) {
#pragma unroll
            for (int r = 0; r < 8 + W - 1; ++r) raw[r] = rawN[r]; }
    }
}

#define O2_TILE(k) ((int)(blockIdx.x & 7) * 192 + (int)(blockIdx.x >> 3) + 32 * (k))
#define O2_HEAD_CONSTS(IDX) do { const int id_ = (IDX), hd_ = (id_ % 192) % 12, jch_ = 16 * wave + c, ch_ = hd_ * 128 + jch_; \
        const bf16_t* RGT_ = (const bf16_t*)(p.ws + WS_RGT) + (size_t)(j * 12 + hd_) * 16384 + (size_t)jch_ * 128 + 8 * q; \
        const bf16_t* IGT_ = (const bf16_t*)(p.ws + WS_IGT) + (size_t)(j * 12 + hd_) * 16384 + (size_t)jch_ * 128 + 8 * q; \
        _Pragma("unroll") for (int ks = 0; ks < 4; ++ks) { Br[ks] = *(const bf16x8*)(RGT_ + 32 * ks); Bi[ks] = *(const bf16x8*)(IGT_ + 32 * ks); } \
        brg = p.b_rg[j * WL + ch_]; big = p.b_ig[j * WL + ch_]; lam = p.lru_lambda[j * WL + ch_]; \
        _Pragma("unroll") for (int k = 0; k < 4; ++k) cw[k] = *(const f32x4*)(p.conv_c_w + (size_t)(j * 4 + k) * WL + hd_ * 128 + c4); \
        cb = *(const f32x4*)(p.conv_c_b + j * WL + hd_ * 128 + c4); } while (0)
__device__ __forceinline__ void o2_phase(const Params& p, unsigned char* lds, int j, int tid, int wave, int lane, const bool dummy) {
    const bf16_t* XR = (const bf16_t*)(p.ws + WS_ACT); const bf16_t* SG = (const bf16_t*)(p.ws + WS_ACT + 48 * MB); bf16_t* W0 = dummy ? (bf16_t*)p.out - WS_HB / 2 : (bf16_t*)p.ws;
    float* XCF = (float*)lds;
    bf16_t* XCB = (bf16_t*)(lds + 128 * 528);
    const int c = lane & 15, q = lane >> 4;
    const int c4 = (lane & 31) * 4, tok0 = 16 * wave + 8 * (lane >> 5);
    const int oc4 = 16 * wave + (lane & 3) * 4, orow = lane >> 2;
    u32x2 xw[11], sgv[8];
    bf16x8 Br[4], Bi[4]; float brg, big, lam; f32x4 cw[4], cb;
    O2_HEAD_CONSTS(O2_TILE(0));
    { const int id = O2_TILE(0), b = id / 192, u_ = id % 192, chunk = u_ / 12, hd = u_ % 12, t0 = chunk * 128, chb = hd * 128;
      const bf16_t* src = XR + (size_t)b * SEQ * WL + chb + c4;
#pragma unroll
      for (int r = 0; r < 11; ++r) { const int t = t0 + tok0 - 3 + r; xw[r] = *(const u32x2*)(src + (size_t)(t < 0 ? 0 : t) * WL); }
      const size_t obase = ((size_t)b * SEQ + t0 + orow) * WL + chb + oc4;
#pragma unroll
      for (int k = 0; k < 8; ++k) sgv[k] = *(const u32x2*)(SG + obase + (size_t)(16 * k) * WL); }
#pragma unroll 1
    for (int k_ = 0; k_ < 6; ++k_) {
        const int id = O2_TILE(k_), b = id / 192, u_ = id % 192, chunk = u_ / 12, hd = u_ % 12, bh = b * 12 + hd, t0 = chunk * 128, chb = hd * 128;
        const int jch = 16 * wave + c, ch = chb + jch;
        {
            f32x4 xv[11];
#pragma unroll
            for (int r = 0; r < 11; ++r) { const bool in = (t0 + tok0 - 3 + r) >= 0; xv[r] = in ? (f32x4){bf_lo(xw[r].x), bf_hi(xw[r].x), bf_lo(xw[r].y), bf_hi(xw[r].y)} : (f32x4){0.f, 0.f, 0.f, 0.f}; }
#pragma unroll
            for (int i = 0; i < 8; ++i) { f32x4 v = cb;
#pragma unroll
                for (int k = 0; k < 4; ++k) v += cw[k] * xv[i + k];
                *(f32x4*)(XCF + (tok0 + i) * 132 + c4) = v;
                u32x2 o; o.x = cvt_pk_bf16(v[0], v[1]); o.y = cvt_pk_bf16(v[2], v[3]); *(u32x2*)(XCB + (tok0 + i) * 136 + c4) = o; }
        }
        lds_barrier();
        const float e_ = __expf(-lam); const float sp8 = 8.0f * (e_ < 0.0625f ? e_ * (1.0f - e_ * (0.5f - e_ * ((1.0f / 3.0f) - e_ * (0.25f - e_ * 0.2f)))) : __logf(1.0f + e_));
#pragma unroll
        for (int ks = 0; ks < 4; ++ks) asm volatile("" :: "v"(Br[ks]), "v"(Bi[ks]));
        asm volatile("" :: "v"(brg), "v"(big), "v"(sp8));
        { const int idN = O2_TILE(k_ < 5 ? k_ + 1 : k_), bN = idN / 192, uN = idN % 192, chunkN = uN / 12, hdN = uN % 12, t0N = chunkN * 128, chbN = hdN * 128;
          const bf16_t* src = XR + (size_t)bN * SEQ * WL + chbN + c4;
#pragma unroll
          for (int r = 0; r < 11; ++r) { const int t = t0N + tok0 - 3 + r; xw[r] = *(const u32x2*)(src + (size_t)(t < 0 ? 0 : t) * WL); }
        }
        float hz[8][4], pt[8][4];
        float Cz = 0.f, Pc = 1.f;
        if ((PROBE & 64) && dummy) {
#pragma unroll
            for (int s = 0; s < 8; ++s)
#pragma unroll
                for (int i = 0; i < 4; ++i) { hz[s][i] = 0.f; pt[s][i] = 1.f; } }
        else
#pragma unroll
        for (int s = 0; s < 8; ++s) {
            bf16x8 Af[4];
#pragma unroll
            for (int ks = 0; ks < 4; ++ks) Af[ks] = *(const bf16x8*)(XCB + (16 * s + c) * 136 + 32 * ks + 8 * q);
            f32x4 aR = (f32x4){0.f, 0.f, 0.f, 0.f}, aI = (f32x4){0.f, 0.f, 0.f, 0.f};
#pragma unroll
            for (int ks = 0; ks < 4; ++ks) { aR = __builtin_amdgcn_mfma_f32_16x16x32_bf16(Af[ks], Br[ks], aR, 0, 0, 0); aI = __builtin_amdgcn_mfma_f32_16x16x32_bf16(Af[ks], Bi[ks], aI, 0, 0, 0); }
            float ph = 0.f, pp = 1.f, hl[4], pl[4];
            float av[4], bv[4];
#pragma unroll
            for (int h2 = 0; h2 < 2; ++h2) {
                const f32x2 xc = (f32x2){XCF[(16 * s + 4 * q + 2 * h2) * 132 + jch], XCF[(16 * s + 4 * q + 2 * h2 + 1) * 132 + jch]};
                const f32x2 zr = ((f32x2){aR[2 * h2], aR[2 * h2 + 1]} + brg) * (-1.44269504f), zi = ((f32x2){aI[2 * h2], aI[2 * h2 + 1]} + big) * (-1.44269504f);
                f32x2 er, ei; er.x = __builtin_amdgcn_exp2f(zr.x); er.y = __builtin_amdgcn_exp2f(zr.y); ei.x = __builtin_amdgcn_exp2f(zi.x); ei.y = __builtin_amdgcn_exp2f(zi.y);
                const f32x2 dr = er + 1.0f, di = ei + 1.0f;
                f32x2 r, ig; r.x = __builtin_amdgcn_rcpf(dr.x); r.y = __builtin_amdgcn_rcpf(dr.y); ig.x = __builtin_amdgcn_rcpf(di.x); ig.y = __builtin_amdgcn_rcpf(di.y);
                const f32x2 x2 = r * (2.0f * sp8), la2 = r * (-1.44269504f * sp8);
                f32x2 a; a.x = __builtin_amdgcn_exp2f(la2.x); a.y = __builtin_amdgcn_exp2f(la2.y);
                const f32x2 ser = x2 * (1.0f - x2 * (0.5f - x2 * (1.0f / 6.0f))), dir = 1.0f - a * a;
                f32x2 om; om.x = x2.x < 0.015625f ? ser.x : dir.x; om.y = x2.y < 0.015625f ? ser.y : dir.y;
                f32x2 sq; sq.x = __builtin_amdgcn_sqrtf(om.x); sq.y = __builtin_amdgcn_sqrtf(om.y);
                const f32x2 bt = sq * (ig * xc);
                av[2 * h2] = a.x; av[2 * h2 + 1] = a.y; bv[2 * h2] = bt.x; bv[2 * h2 + 1] = bt.y;
            }
#pragma unroll
            for (int i = 0; i < 4; ++i) { ph = av[i] * ph + bv[i]; pp = pp * av[i]; hl[i] = ph; pl[i] = pp; }
            float P4 = pp, H4 = ph;
            { const float Pp = __shfl_up(P4, 16), Hp = __shfl_up(H4, 16); if (q >= 1) { H4 = P4 * Hp + H4; P4 = P4 * Pp; } }
            { const float Pp = __shfl_up(P4, 32), Hp = __shfl_up(H4, 32); if (q >= 2) { H4 = P4 * Hp + H4; P4 = P4 * Pp; } }
            float Pe = __shfl_up(P4, 16), He = __shfl_up(H4, 16); if (q == 0) { Pe = 1.f; He = 0.f; }
            const float Pt = __shfl(P4, 48 + c), Ht = __shfl(H4, 48 + c);
            const float Hs = Pe * Cz + He, Ps = Pe * Pc;
#pragma unroll
            for (int i = 0; i < 4; ++i) { hz[s][i] = hl[i] + pl[i] * Hs; pt[s][i] = pl[i] * Ps; }
            Cz = Pt * Cz + Ht; Pc = Pt * Pc;
        }
        unsigned long long* slots = (unsigned long long*)(p.ws + WS_CARRY) + ((size_t)((dummy ? j + 2 : j) * 16) * 96 + bh) * 128 + jch;
        if (chunk < 15 && q == 0)
            __hip_atomic_store(slots + (size_t)chunk * 96 * 128, ((unsigned long long)(__float_as_uint(Pc) | 0x80000000u) << 32) | (unsigned long long)__float_as_uint(Cz), __ATOMIC_RELAXED, __HIP_MEMORY_SCOPE_AGENT);
        float Hc = 0.f;
#pragma unroll
        for (int hb_ = 0; hb_ < 2; ++hb_) {
            if (chunk > 8 * hb_) {
                unsigned* tmo = (unsigned*)(p.ws + WS_CTL) + CW_TMO2; unsigned spins = 0u; unsigned long long va[8];
                for (;;) { bool ok = true;
#pragma unroll
                    for (int pc = 0; pc < 8; ++pc) if (8 * hb_ + pc < chunk) va[pc] = __hip_atomic_load(slots + (size_t)(8 * hb_ + pc) * 96 * 128, __ATOMIC_RELAXED, __HIP_MEMORY_SCOPE_AGENT);
#pragma unroll
                    for (int pc = 0; pc < 8; ++pc) if (8 * hb_ + pc < chunk) ok = ok && (((unsigned)(va[pc] >> 32) & 0x80000000u) != 0u);
                    if (__all(ok)) break;
                    __builtin_amdgcn_s_sleep(1);
                    if ((++spins & 255u) == 0u) { if (__hip_atomic_load(tmo, __ATOMIC_RELAXED, __HIP_MEMORY_SCOPE_AGENT) != 0u) break; if (spins > (1u << 19)) { __hip_atomic_store(tmo, 1u, __ATOMIC_RELAXED, __HIP_MEMORY_SCOPE_AGENT); break; } } }
#pragma unroll
                for (int pc = 0; pc < 8; ++pc) if (8 * hb_ + pc < chunk) Hc = __uint_as_float((unsigned)(va[pc] >> 32) & 0x7fffffffu) * Hc + __uint_as_float((unsigned)va[pc]);
            }
        }
        O2_HEAD_CONSTS(O2_TILE(k_ < 5 ? k_ + 1 : k_));
#pragma unroll
        for (int s = 0; s < 8; ++s)
#pragma unroll
            for (int i = 0; i < 4; ++i) XCF[(16 * s + 4 * q + i) * 132 + jch] = hz[s][i] + pt[s][i] * Hc;
        asm volatile("s_waitcnt lgkmcnt(0)" ::: "memory");
        const size_t obase = ((size_t)b * SEQ + t0 + orow) * WL + chb + oc4;
#pragma unroll
        for (int k = 0; k < 8; ++k) { const f32x4 h = *(const f32x4*)(XCF + (orow + 16 * k) * 132 + oc4); const u32x2 g = sgv[k];
            u32x2 ow; ow.x = cvt_pk_bf16(h[0] * bf_lo(g.x), h[1] * bf_hi(g.x)); ow.y = cvt_pk_bf16(h[2] * bf_lo(g.y), h[3] * bf_hi(g.y));
            const size_t oo = dummy ? WS_HB / 2 + ((size_t)b * SEQ + t0 + orow + 16 * k) * 1024 + ((chb + oc4) & 1023) : (WS_ACT + 48 * MB) / 2 + obase + (size_t)(16 * k) * WL;
            *(u32x2*)(W0 + oo) = ow; }
        lds_barrier();
        { const int idN = O2_TILE(k_ < 5 ? k_ + 1 : k_), bN = idN / 192, uN = idN % 192, chunkN = uN / 12, hdN = uN % 12, t0N = chunkN * 128, chbN = hdN * 128;
          const size_t obaseN = ((size_t)bN * SEQ + t0N + orow) * WL + chbN + oc4;
#pragma unroll
          for (int k = 0; k < 8; ++k) sgv[k] = *(const u32x2*)(SG + obaseN + (size_t)(16 * k) * WL); }
    }
}

typedef const __attribute__((address_space(4))) Params* KP;
#define GRID_BAR() do { KP qb_ = kp; asm volatile("" : "+s"(qb_)); XcdBarrier b_; b_.bar = (unsigned*)(qb_->ws + WS_CTL); b_.x = xb_xcc_id(); b_.st = (volatile LAS unsigned*)(ldsl + CTL_OFF); xcd_barrier(b_); } while (0)
#define PHASE_ARGS() KP qk_ = kp; asm volatile("" : "+s"(qk_)); Params pl; { const __attribute__((address_space(4))) unsigned long long* s_ = (const __attribute__((address_space(4))) unsigned long long*)qk_; char** d_ = (char**)&pl; _Pragma("unroll") for (int i_ = 0; i_ < 24; ++i_) d_[i_] = (char*)(__attribute__((address_space(1))) char*)s_[i_]; }     unsigned char* ws = pl.ws; \
    int wv = wave0_; asm volatile("" : "+s"(wv)); unsigned m1_ = ~0u; asm volatile("" : "+s"(m1_)); int ln = (int)__builtin_amdgcn_mbcnt_hi(m1_, __builtin_amdgcn_mbcnt_lo(m1_, 0u)); asm volatile("" : "+v"(ln)); const int tl = wv * 64 + ln; (void)tl; (void)ws
__global__ void __launch_bounds__(512, 2) trunk_fwd(Params p_unused) {
    extern __shared__ __attribute__((aligned(16))) unsigned char lds_raw[];
    LAS unsigned char* ldsl = (LAS unsigned char*)lds_raw;
    const KP kp = (KP)__builtin_amdgcn_kernarg_segment_ptr();
    const int G = gridDim.x;
    const int wave0_ = __builtin_amdgcn_readfirstlane((int)threadIdx.x >> 6);
    { PHASE_ARGS();
      if (tl < 16) ((LAS unsigned*)(ldsl + CTL_OFF))[tl] = 0u;
      __syncthreads();
      (void)xcd_barrier_post((unsigned*)(ws + WS_CTL), (volatile LAS unsigned*)(ldsl + CTL_OFF));
      _Pragma("unroll 1") for (int rep = 0; rep < ((PROBE & 8) ? 2 : 1); ++rep) p0_prologue(pl, lds_raw, wv, ln);
    }
    GRID_BAR();
    if (PROBE & 32) { _Pragma("unroll 1") for (int rep = 0; rep < 8; ++rep) GRID_BAR(); }
#pragma unroll 1
    for (int layer = 0; layer < 4; ++layer) {
        const int j = layer >> 1;
        if ((layer & 1) == 0) {
            { PHASE_ARGS(); float* ssq = (float*)(ws + WS_SSQ); bf16_t* HB = (bf16_t*)(ws + WS_HB);
              pg8::Gemm g{HB, (const bf16_t*)(ws + WS_WINE) + (size_t)j * 5120 * 1024, M, 5120, 1024}; pg8::StaticOrder S; S.init(M, 5120, G, (int)blockIdx.x);
              { const int pm_ = 8 * (int)(blockIdx.x & 7) + (int)((blockIdx.x >> 3) & 7);
                if (tl < 256) { const int row = 256 * pm_ + tl; float sq = 0.f;
                    _Pragma("unroll") for (int q_ = 0; q_ < 16; ++q_) sq += ssq[(size_t)q_ * M + row];
                    ((LAS float*)(ldsl + CTL_OFF + 1024))[tl] = rsqrtf(sq * (1.0f / 1024.0f) + 1e-6f); }
                __syncthreads(); }
              pg8::EpiE1 E{(const LAS float*)(ldsl + CTL_OFF + 1024), (bf16_t*)(ws + WS_ACT)};
              _Pragma("unroll 1") for (int rep = 0; rep < ((PROBE & 1) ? 2 : 1); ++rep) pg8::gemm_phase<pg8::EpiE1, pg8::StaticOrder, true, true>(ldsl, g, S, E, tl); }
            GRID_BAR();
            _Pragma("unroll 1") for (int rep = ((PROBE & 2) ? 0 : 1); rep < 2; ++rep) {
            #ifndef NO_CONV
            { PHASE_ARGS(); e2_conv_phase(pl, lds_raw, j, tl, wv, ln, (PROBE & 2) && rep == 0); }
#endif
#ifndef NO_POOL
            { PHASE_ARGS(); const int g_ = (int)(blockIdx.x >> 3) & 3; const bool dm = (PROBE & 2) && rep == 0;
              if (g_ == 0) e2_pool_phase<2>(pl, lds_raw, j, 0, wv, ln, dm); else if (g_ == 1) e2_pool_phase<4>(pl, lds_raw, j, 1, wv, ln, dm);
              else if (g_ == 2) e2_pool_phase<8>(pl, lds_raw, j, 2, wv, ln, dm); else e2_pool_phase<16>(pl, lds_raw, j, 3, wv, ln, dm); }
#endif
            }
            GRID_BAR();
            { PHASE_ARGS(); float* ssq = (float*)(ws + WS_SSQ); bf16_t* HB = (bf16_t*)(ws + WS_HB);
              pg8::Gemm g{(const bf16_t*)(ws + WS_ACT + 64 * MB), (const bf16_t*)(ws + WS_WOUTE) + (size_t)j * 1024 * 2048, M, 1024, 2048}; pg8::StaticOrder S; S.init(M, 1024, G, (int)blockIdx.x);
              pg8::EpiRes E{HB, ssq};
              _Pragma("unroll 1") for (int rep = 0; rep < (((PROBE & 16) && layer == 0) ? 2 : 1); ++rep) pg8::gemm_phase<pg8::EpiRes, pg8::StaticOrder, true, true>(ldsl, g, S, E, tl); }
            GRID_BAR();
        } else {
            { PHASE_ARGS(); float* ssq = (float*)(ws + WS_SSQ); bf16_t* HB = (bf16_t*)(ws + WS_HB);
              pg8::Gemm g{HB, (const bf16_t*)(ws + WS_WINO) + (size_t)j * 3072 * 1024, M, 3072, 1024}; pg8::StaticOrder S; S.init(M, 3072, G, (int)blockIdx.x);
              { const int pm_ = 8 * (int)(blockIdx.x & 7) + (int)((blockIdx.x >> 3) & 7);
                if (tl < 256) { const int row = 256 * pm_ + tl; float sq = 0.f;
                    _Pragma("unroll") for (int q_ = 0; q_ < 16; ++q_) sq += ssq[(size_t)q_ * M + row];
                    ((LAS float*)(ldsl + CTL_OFF + 1024))[tl] = rsqrtf(sq * (1.0f / 1024.0f) + 1e-6f); }
                __syncthreads(); }
              pg8::EpiO1 E{(const LAS float*)(ldsl + CTL_OFF + 1024), (bf16_t*)(ws + WS_ACT)};
              _Pragma("unroll 1") for (int rep = 0; rep < ((PROBE & 1) ? 2 : 1); ++rep) pg8::gemm_phase<pg8::EpiO1, pg8::StaticOrder, true, true>(ldsl, g, S, E, tl); }
            GRID_BAR();
            _Pragma("unroll 1") for (int rep = ((PROBE & 4) ? 0 : 1); rep < 2; ++rep)
#ifndef NO_O2
            { PHASE_ARGS(); o2_phase(pl, lds_raw, j, tl, wv, ln, (PROBE & 4) && rep == 0); }
#endif
            GRID_BAR();
            { PHASE_ARGS(); float* ssq = (float*)(ws + WS_SSQ); bf16_t* HB = (bf16_t*)(ws + WS_HB);
              pg8::Gemm g{(const bf16_t*)(ws + WS_ACT + 48 * MB), (const bf16_t*)(ws + WS_WOUTO) + (size_t)j * 1024 * 1536, M, 1024, 1536}; pg8::StaticOrder S; S.init(M, 1024, G, (int)blockIdx.x);
              if (layer == 3) {
                  pg8::EpiFinal E{HB, pl.out, pl.final_norm, ssq, (unsigned*)(ws + WS_CTL) + 4096, (unsigned*)(ws + WS_CTL) + CW_TMO2};
                  pg8::gemm_phase<pg8::EpiFinal, pg8::StaticOrder, false, true>(ldsl, g, S, E, tl);
              } else {
                  pg8::EpiRes E{HB, ssq};
                  pg8::gemm_phase<pg8::EpiRes, pg8::StaticOrder, true, true>(ldsl, g, S, E, tl); } }
            if (layer != 3) GRID_BAR();
        }
    }
}

extern "C" void kernel_launch(void* const* d_in, const int* in_sizes, int n_in, void* d_out, int out_size, void* d_ws, size_t ws_size, hipStream_t stream) {
    static int grid = 0;
    if (grid == 0) {
        if (n_in != 22 || out_size != M * D || ws_size < WS_END) { fprintf(stderr, "kernel_launch: unexpected shapes (n_in %d out %d ws %zu)\n", n_in, out_size, ws_size); grid = -1; return; }
        int dev = 0, cus = 0, per_cu = 0;
        hipGetDevice(&dev); hipDeviceGetAttribute(&cus, hipDeviceAttributeMultiprocessorCount, dev);
        hipFuncSetAttribute((const void*)trunk_fwd, hipFuncAttributeMaxDynamicSharedMemorySize, LDS_BYTES);
        hipOccupancyMaxActiveBlocksPerMultiprocessor(&per_cu, (const void*)trunk_fwd, 512, LDS_BYTES);
        (void)hipGetLastError();
        if (per_cu < 1) { fprintf(stderr, "kernel_launch: occupancy query says %d blocks per CU\n", per_cu); per_cu = 1; }
        grid = 256;
        if (cus < 256) { fprintf(stderr, "kernel_launch: %d CUs < 256\n", cus); grid = -1; return; }
    }
    if (grid < 0) return;
    hipMemsetAsync((char*)d_ws + WS_CTL, 0, 64 * 1024, stream);
    Params p{};
    const float** pp = (const float**)&p;
    for (int i = 0; i < 22; ++i) pp[i] = (const float*)d_in[i];
    p.out = (float*)d_out; p.ws = (unsigned char*)d_ws;
    void* args[] = {&p};
    hipError_t e = hipLaunchCooperativeKernel((const void*)trunk_fwd, dim3(grid), dim3(512), args, LDS_BYTES, stream);
    if (e != hipSuccess) fprintf(stderr, "kernel_launch: cooperative launch failed: %s (grid %d)\n", hipGetErrorString(e), grid);
}
```

```cpp
#include <hip/hip_runtime.h>
#include <cstdio>
#include <cstdint>
namespace pg8 {
#define PG8_LAS __attribute__((address_space(3)))
typedef unsigned short bf16_t;
typedef short bf16x8 __attribute__((ext_vector_type(8)));
typedef float f32x4 __attribute__((ext_vector_type(4)));
typedef unsigned u32x4 __attribute__((ext_vector_type(4)));
constexpr int BM = 256, BK = 64, HALF = 128, HTB = HALF * BK * 2  , STAGE_BYTES = 8 * HTB, NXCD = 8, WGM = 8;

__host__ __device__ __forceinline__ int lds_byte(int r, int c) { const int st = (r >> 4) * 2 + (c >> 5), rr = r & 15, cc = c & 31, ob = rr * 64 + cc * 2; return st * 1024 + (ob ^ (((ob >> 9) & 1) << 5)); }
__host__ __device__ __forceinline__ void stage_rc(int b, int& R, int& C) { const int st = b / 1024, sb = b % 1024, swz = sb ^ (((sb >> 9) & 1) << 5); R = (st >> 1) * 16 + swz / 64; C = (st & 1) * 32 + (swz % 64) / 2; }
__host__ __device__ __forceinline__ int perm32(int rho) { const int n = rho >> 4, i = rho & 15; return 8 * (i >> 2) + 4 * n + (i & 3); }

struct Unit { int pm, pn; };
struct Gemm { const bf16_t* A; const bf16_t* Bt; int M, N, K; };

struct StaticOrder {
    int nM, nN, nwg, G, c;
    __host__ __device__ void init(int M, int N, int G_, int c_) { nM = M / BM; nN = N / BM; nwg = nM * nN; G = G_; c = c_; }
    __host__ __device__ bool next(int i, Unit& u) const {
        const long L = (long)i * G + c; if (L >= nwg) return false;
        int wgid = (int)L; { const int q = nwg / NXCD, r = nwg % NXCD, xcd = wgid % NXCD, off = wgid / NXCD; wgid = (xcd < r ? xcd * (q + 1) : r * (q + 1) + (xcd - r) * q) + off; }
        const int nig = WGM * nN, gid = wgid / nig, fm = gid * WGM, gsz = (nM - fm) < WGM ? (nM - fm) : WGM;
        u.pm = fm + ((wgid % nig) % gsz); u.pn = (wgid % nig) / gsz; return true;
    }
    __device__ __forceinline__ void a_ready(const Unit&) const {}
    __device__ __forceinline__ void done(const Unit&) const {}
};
__device__ __forceinline__ unsigned cvt_pk_bf16(float lo, float hi) { unsigned r; asm volatile("v_cvt_pk_bf16_f32 %0, %1, %2" : "=v"(r) : "v"(lo), "v"(hi)); return r; }
__device__ __forceinline__ float sigm(float x) { return __builtin_amdgcn_rcpf(1.0f + __expf(-x)); }
constexpr int MROWS = 16384;
__device__ __forceinline__ f32x4 sigm4(f32x4 v) { const f32x4 z = v * (-1.44269504f); f32x4 e; e[0] = __builtin_amdgcn_exp2f(z[0]); e[1] = __builtin_amdgcn_exp2f(z[1]); e[2] = __builtin_amdgcn_exp2f(z[2]); e[3] = __builtin_amdgcn_exp2f(z[3]);
    const f32x4 d = e + 1.0f; f32x4 r; r[0] = __builtin_amdgcn_rcpf(d[0]); r[1] = __builtin_amdgcn_rcpf(d[1]); r[2] = __builtin_amdgcn_rcpf(d[2]); r[3] = __builtin_amdgcn_rcpf(d[3]); return r; }

struct EpiE1 {
    static constexpr bool PERM = true, AFTER_DRAIN = false;
    const PG8_LAS float* rsl; bf16_t* U;
    __device__ __forceinline__ void operator()(const f32x4 (&acc)[2][2][4][2], const Unit& u, int wr, int wc, int fr, int fq) const {
        const __amdgpu_buffer_rsrc_t rsrc = __builtin_amdgcn_make_buffer_rsrc((void*)U, 0, 0x08000000, 0x00020000);
        const int row0 = u.pm * BM + wr * 64 + fr, c8 = wc * 32 + 8 * fq;
        float rs[2][4];
#pragma unroll
        for (int ai = 0; ai < 2; ++ai)
#pragma unroll
            for (int m = 0; m < 4; ++m) rs[ai][m] = rsl[wr * 64 + ai * HALF + m * 16 + fr];
        if (u.pn < 8) {
#pragma unroll
            for (int ai = 0; ai < 2; ++ai)
#pragma unroll
                for (int m = 0; m < 4; ++m) { const float r = rs[ai][m]; bf16_t* rowp = U + (size_t)(row0 + ai * HALF + m * 16) * 1024 + u.pn * 128 + c8;
                    const f32x4 o0 = (acc[ai][0][m][0] * r) * sigm4(acc[ai][1][m][0] * r), o1 = (acc[ai][0][m][1] * r) * sigm4(acc[ai][1][m][1] * r);
                    u32x4 w; w.x = cvt_pk_bf16(o0[0], o0[1]); w.y = cvt_pk_bf16(o0[2], o0[3]); w.z = cvt_pk_bf16(o1[0], o1[1]); w.w = cvt_pk_bf16(o1[2], o1[3]);
                    __builtin_amdgcn_raw_buffer_store_b128(w, rsrc, (unsigned)((const char*)rowp - (const char*)U), 0, 16); }
        } else {
            const bool act = (u.pn < 12) || (u.pn >= 16); const bool isbv = !act;
            const int ldc = isbv ? 1024 : 2048, colt = (u.pn < 12) ? (u.pn - 8) * 256 : (isbv ? (u.pn - 12) * 256 : 1024 + (u.pn - 16) * 256);
            bf16_t* base = U + (isbv ? (size_t)16 * 1024 * 1024 : (size_t)32 * 1024 * 1024);
#pragma unroll
            for (int ai = 0; ai < 2; ++ai)
#pragma unroll
                for (int m = 0; m < 4; ++m) { const float r = rs[ai][m]; bf16_t* rowp = base + (size_t)(row0 + ai * HALF + m * 16) * ldc + colt + c8;
#pragma unroll
                    for (int bj = 0; bj < 2; ++bj) { f32x4 o0 = acc[ai][bj][m][0] * r, o1 = acc[ai][bj][m][1] * r;
                        if (act) { o0 = o0 * sigm4(o0); o1 = o1 * sigm4(o1); }
                        u32x4 w; w.x = cvt_pk_bf16(o0[0], o0[1]); w.y = cvt_pk_bf16(o0[2], o0[3]); w.z = cvt_pk_bf16(o1[0], o1[1]); w.w = cvt_pk_bf16(o1[2], o1[3]);
                        __builtin_amdgcn_raw_buffer_store_b128(w, rsrc, (unsigned)((const char*)(rowp + bj * HALF) - (const char*)U), 0, 16); } }
        }
    }
};
struct EpiO1 {
    static constexpr bool PERM = true, AFTER_DRAIN = false;
    const PG8_LAS float* rsl; bf16_t* XR;
    __device__ __forceinline__ void operator()(const f32x4 (&acc)[2][2][4][2], const Unit& u, int wr, int wc, int fr, int fq) const {
        const __amdgpu_buffer_rsrc_t rsrc = __builtin_amdgcn_make_buffer_rsrc((void*)XR, 0, 0x08000000, 0x00020000);
        const int row0 = u.pm * BM + wr * 64 + fr, c8 = wc * 32 + 8 * fq;
        float rs[2][4];
#pragma unroll
        for (int ai = 0; ai < 2; ++ai)
#pragma unroll
            for (int m = 0; m < 4; ++m) rs[ai][m] = rsl[wr * 64 + ai * HALF + m * 16 + fr];
        const bool act = u.pn >= 6;
        bf16_t* base = XR + (act ? (size_t)24 * 1024 * 1024 : (size_t)0); const int colt = (act ? u.pn - 6 : u.pn) * 256;
#pragma unroll
        for (int ai = 0; ai < 2; ++ai)
#pragma unroll
            for (int m = 0; m < 4; ++m) { const float r = rs[ai][m]; bf16_t* rowp = base + (size_t)(row0 + ai * HALF + m * 16) * 1536 + colt + c8;
#pragma unroll
                for (int bj = 0; bj < 2; ++bj) { f32x4 o0 = acc[ai][bj][m][0] * r, o1 = acc[ai][bj][m][1] * r;
                    if (act) { o0 = o0 * sigm4(o0); o1 = o1 * sigm4(o1); }
                    u32x4 w; w.x = cvt_pk_bf16(o0[0], o0[1]); w.y = cvt_pk_bf16(o0[2], o0[3]); w.z = cvt_pk_bf16(o1[0], o1[1]); w.w = cvt_pk_bf16(o1[2], o1[3]);
                    __builtin_amdgcn_raw_buffer_store_b128(w, rsrc, (unsigned)((const char*)(rowp + bj * HALF) - (const char*)XR), 0, 16); } }
    }
};
struct EpiRes {
    static constexpr bool PERM = true, AFTER_DRAIN = false;
    bf16_t* HB; float* ssq;
    __device__ __forceinline__ void operator()(const f32x4 (&acc)[2][2][4][2], const Unit& u, int wr, int wc, int fr, int fq) const {
        const int row0 = u.pm * BM + wr * 64 + fr, col0 = u.pn * BM + wc * 32 + 8 * fq;
#pragma unroll
        for (int ai = 0; ai < 2; ++ai)
#pragma unroll
            for (int m = 0; m < 4; ++m) { const int row = row0 + ai * HALF + m * 16; bf16_t* rowp = HB + (size_t)row * 1024 + col0; float s = 0.f;
#pragma unroll
                for (int bj = 0; bj < 2; ++bj) { const u32x4 b = *(const u32x4*)(rowp + bj * HALF); float o[8];
                    const float bb[8] = {__uint_as_float(b.x << 16), __uint_as_float(b.x & 0xffff0000u), __uint_as_float(b.y << 16), __uint_as_float(b.y & 0xffff0000u),
                                         __uint_as_float(b.z << 16), __uint_as_float(b.z & 0xffff0000u), __uint_as_float(b.w << 16), __uint_as_float(b.w & 0xffff0000u)};
#pragma unroll
                    for (int n = 0; n < 2; ++n)
#pragma unroll
                        for (int e = 0; e < 4; ++e) { o[4 * n + e] = bb[4 * n + e] + acc[ai][bj][m][n][e]; s += o[4 * n + e] * o[4 * n + e]; }
                    u32x4 w; w.x = cvt_pk_bf16(o[0], o[1]); w.y = cvt_pk_bf16(o[2], o[3]); w.z = cvt_pk_bf16(o[4], o[5]); w.w = cvt_pk_bf16(o[6], o[7]);
                    *(u32x4*)(rowp + bj * HALF) = w; }
                s += __shfl_xor(s, 16); s += __shfl_xor(s, 32);
                if (fq == 0) ssq[(size_t)(u.pn * 4 + wc) * MROWS + row] = s; }
    }
};
struct EpiFinal {
    static constexpr bool PERM = true, AFTER_DRAIN = true;
    const bf16_t* HB; float* out; const float* gain; float* xbuf; unsigned* cnt; unsigned* tmo;
    __device__ __forceinline__ void fused(f32x4 (&acc)[2][2][4][2], const Unit& u, int wr, int wc, int fr, int fq, PG8_LAS unsigned char* lds, int wid, int lane) const {
        PG8_LAS float* P = (PG8_LAS float*)lds;
        PG8_LAS float* R = (PG8_LAS float*)(lds + 4096);
        const int row0 = u.pm * BM + wr * 64 + fr, col0 = u.pn * BM + wc * 32 + 8 * fq;
#pragma unroll
        for (int ai = 0; ai < 2; ++ai)
#pragma unroll
            for (int m = 0; m < 4; ++m) { const int row = row0 + ai * HALF + m * 16; const bf16_t* rowp = HB + (size_t)row * 1024 + col0; float s = 0.f;
#pragma unroll
                for (int bj = 0; bj < 2; ++bj) { const u32x4 b = *(const u32x4*)(rowp + bj * HALF);
                    const f32x4 b0 = (f32x4){__uint_as_float(b.x << 16), __uint_as_float(b.x & 0xffff0000u), __uint_as_float(b.y << 16), __uint_as_float(b.y & 0xffff0000u)};
                    const f32x4 b1 = (f32x4){__uint_as_float(b.z << 16), __uint_as_float(b.z & 0xffff0000u), __uint_as_float(b.w << 16), __uint_as_float(b.w & 0xffff0000u)};
                    acc[ai][bj][m][0] += b0; acc[ai][bj][m][1] += b1;
                    const f32x4 q0 = acc[ai][bj][m][0] * acc[ai][bj][m][0], q1 = acc[ai][bj][m][1] * acc[ai][bj][m][1];
                    s += ((q0[0] + q0[1]) + (q0[2] + q0[3])) + ((q1[0] + q1[1]) + (q1[2] + q1[3])); }
                s += __shfl_xor(s, 16); s += __shfl_xor(s, 32);
                if (fq == 0) P[(wr * 64 + ai * HALF + m * 16 + fr) * 4 + wc] = s; }
        asm volatile("s_waitcnt lgkmcnt(0)" ::: "memory"); __builtin_amdgcn_s_barrier(); asm volatile("" ::: "memory");
        const int row = wid * 32 + (lane & 31);
        if (lane < 32) { const float t = (P[row * 4 + 0] + P[row * 4 + 1]) + (P[row * 4 + 2] + P[row * 4 + 3]);
            __hip_atomic_store(xbuf + (size_t)(u.pm * BM + row) * 4 + u.pn, t, __ATOMIC_RELAXED, __HIP_MEMORY_SCOPE_AGENT); }
        asm volatile("s_waitcnt vmcnt(0)" ::: "memory");
        if (lane == 0) __hip_atomic_fetch_add(cnt + 64 * u.pm, 1u, __ATOMIC_RELAXED, __HIP_MEMORY_SCOPE_AGENT);
        if (wid == 0) { unsigned spins = 0u;
            while ((unsigned)__builtin_amdgcn_readfirstlane(__hip_atomic_load(cnt + 64 * u.pm, __ATOMIC_RELAXED, __HIP_MEMORY_SCOPE_AGENT)) < 32u) {
                __builtin_amdgcn_s_sleep(1);
                if ((++spins & 255u) == 0u) { if (__hip_atomic_load(tmo, __ATOMIC_RELAXED, __HIP_MEMORY_SCOPE_AGENT) != 0u) break; if (spins > (1u << 19)) { if (lane == 0) __hip_atomic_store(tmo, 1u, __ATOMIC_RELAXED, __HIP_MEMORY_SCOPE_AGENT); break; } } }
            __builtin_amdgcn_fence(__ATOMIC_ACQUIRE, "agent"); }
        asm volatile("s_waitcnt vmcnt(0) lgkmcnt(0)" ::: "memory"); __builtin_amdgcn_s_barrier(); asm volatile("" ::: "memory");
        if (lane < 32) { const float* xs = xbuf + (size_t)(u.pm * BM + row) * 4; float t = 0.f;
#pragma unroll
            for (int k = 0; k < 4; ++k) t += __hip_atomic_load(xs + k, __ATOMIC_RELAXED, __HIP_MEMORY_SCOPE_AGENT);
            R[row] = rsqrtf(t * (1.0f / 1024.0f) + 1e-6f); }
        asm volatile("s_waitcnt lgkmcnt(0)" ::: "memory"); __builtin_amdgcn_s_barrier(); asm volatile("" ::: "memory");
        f32x4 gv[2][2];
#pragma unroll
        for (int bj = 0; bj < 2; ++bj)
#pragma unroll
            for (int n = 0; n < 2; ++n) gv[bj][n] = *(const f32x4*)(gain + col0 + bj * HALF + 4 * n);
#pragma unroll
        for (int ai = 0; ai < 2; ++ai)
#pragma unroll
            for (int m = 0; m < 4; ++m) { const int rl = wr * 64 + ai * HALF + m * 16 + fr; const float r = R[rl]; float* op = out + (size_t)(u.pm * BM + rl) * 1024 + col0;
#pragma unroll
                for (int bj = 0; bj < 2; ++bj)
#pragma unroll
                    for (int n = 0; n < 2; ++n) *(f32x4*)(op + bj * HALF + 4 * n) = acc[ai][bj][m][n] * r * gv[bj][n]; }
    }
};
template <class Epi, class Sched, bool ALIGN_EPI = false, bool SP2 = false>
__device__ __forceinline__ void gemm_phase(PG8_LAS unsigned char* lds, const Gemm g, const Sched& S, const Epi& E, const int tid_in) {
    int tid_ = tid_in; asm volatile("" : "+v"(tid_));
    const int tid = tid_, wid = __builtin_amdgcn_readfirstlane(tid >> 6), lane = tid & 63, wr = wid >> 2, wc = wid & 3, fr = lane & 15, fq = lane >> 4;
    const int K = g.K, nt = K / BK;
    unsigned voffA[2], voffB[2];
#pragma unroll
    for (int i = 0; i < 2; ++i) { int R, C; stage_rc(tid * 16 + i * 8192, R, C); const int Rb = Epi::PERM ? ((R & ~31) + perm32(R & 31)) : R;
        voffA[i] = (unsigned)(R * K + C) * 2u; voffB[i] = (unsigned)(Rb * K + C) * 2u; }
    const size_t kstep = (size_t)(BK * 2);
    const size_t hstep = (size_t)HALF * K * 2;
    const size_t tstep = 2 * hstep;
    const unsigned ldsw = (unsigned)wid * 1024u;
    const int aoff = lds_byte(wr * 64 + fr, fq * 8), boff = lds_byte(wc * 32 + fr, fq * 8);
#define PG8_SA(b, h) (((b) * 2 + (h)) * HTB)
#define PG8_SB(b, h) ((4 + (b) * 2 + (h)) * HTB)
#define PG8_STAGE(bufoff, gbase, voff) do { _Pragma("unroll") for (int _i = 0; _i < 2; ++_i) \
        __builtin_amdgcn_global_load_lds((const unsigned*)((const char*)(gbase) + (voff)[_i]), (PG8_LAS unsigned*)(lds + (bufoff) + ldsw + _i * 8192), 16, 0, 0); } while (0)
#define PG8_LDA(dst, b, h) do { _Pragma("unroll") for (int m = 0; m < 4; ++m) _Pragma("unroll") for (int k = 0; k < 2; ++k) dst[m][k] = *(const PG8_LAS bf16x8*)(lds + PG8_SA(b, h) + aoff + m * 2048 + k * 1024); } while (0)
#define PG8_LDB(dst, b, h) do { _Pragma("unroll") for (int n = 0; n < 2; ++n) _Pragma("unroll") for (int k = 0; k < 2; ++k) dst[n][k] = *(const PG8_LAS bf16x8*)(lds + PG8_SB(b, h) + boff + n * 2048 + k * 1024); } while (0)
#define PG8_MMA(ai, bj, At, Bt) do { __builtin_amdgcn_s_setprio(1); _Pragma("unroll") for (int m = 0; m < 4; ++m) _Pragma("unroll") for (int n = 0; n < 2; ++n) _Pragma("unroll") for (int k = 0; k < 2; ++k) \
        acc[ai][bj][m][n] = __builtin_amdgcn_mfma_f32_16x16x32_bf16(Bt[n][k], At[m][k], acc[ai][bj][m][n], 0, 0, 0); __builtin_amdgcn_s_setprio(0); } while (0)
#define PG8_WAIT_V(n) asm volatile("s_waitcnt vmcnt(" #n ")" ::: "memory")
#define PG8_WAIT_L(n) asm volatile("s_waitcnt lgkmcnt(" #n ")" ::: "memory")
#define PG8_BAR __builtin_amdgcn_s_barrier()
#define PG8_SCHED __builtin_amdgcn_sched_barrier(0)
    Unit cur, nxt; int ui = 0;
    if (!S.next(0, cur)) return;
    f32x4 acc[2][2][4][2];
#pragma unroll
    for (int a = 0; a < 2; ++a)
#pragma unroll
        for (int b = 0; b < 2; ++b)
#pragma unroll
            for (int m = 0; m < 4; ++m)
#pragma unroll
                for (int n = 0; n < 2; ++n) acc[a][b][m][n] = (f32x4){0.f, 0.f, 0.f, 0.f};
    bf16x8 At[4][2], B0[2][2], B1[2][2];
    const char* cA = (const char*)g.A + (size_t)cur.pm * tstep; const char* cB = (const char*)g.Bt + (size_t)cur.pn * tstep;
    S.a_ready(cur);
    if constexpr (SP2) {
        PG8_STAGE(PG8_SB(0, 0), cB, voffB); PG8_STAGE(PG8_SB(0, 1), cB + hstep, voffB); PG8_STAGE(PG8_SA(0, 0), cA, voffA); PG8_STAGE(PG8_SA(0, 1), cA + hstep, voffA);
        if (wr == 1) PG8_BAR;
        PG8_WAIT_V(2); PG8_BAR;
        PG8_STAGE(PG8_SB(1, 0), cB + kstep, voffB); PG8_STAGE(PG8_SA(1, 0), cA + kstep, voffA); PG8_STAGE(PG8_SB(1, 1), cB + hstep + kstep, voffB);
        PG8_WAIT_V(6); PG8_BAR;
    } else {
        PG8_STAGE(PG8_SB(0, 0), cB, voffB); PG8_STAGE(PG8_SA(0, 0), cA, voffA); PG8_STAGE(PG8_SB(0, 1), cB + hstep, voffB); PG8_STAGE(PG8_SA(0, 1), cA + hstep, voffA);
        if (wr == 1) PG8_BAR;
        PG8_WAIT_V(4); PG8_BAR;
        PG8_STAGE(PG8_SB(1, 0), cB + kstep, voffB); PG8_STAGE(PG8_SA(1, 0), cA + kstep, voffA); PG8_STAGE(PG8_SB(1, 1), cB + hstep + kstep, voffB);
        PG8_WAIT_V(6); PG8_BAR;
    }
    for (;;) {
        const bool has_next = S.next(ui + 1, nxt);
        const char* nA = has_next ? (const char*)g.A + (size_t)nxt.pm * tstep : cA; const char* nB = has_next ? (const char*)g.Bt + (size_t)nxt.pn * tstep : cB;
        for (int t = 0; t < nt; t += 2) {
            const bool last = (t == nt - 2);
            const char* a1 = cA + (size_t)(t + 1) * kstep;
            const char* a2 = last ? nA : cA + (size_t)(t + 2) * kstep; const char* b2 = last ? nB : cB + (size_t)(t + 2) * kstep;
            const char* a3 = a2 + kstep; const char* b3 = b2 + kstep;
            if (last && has_next) S.a_ready(nxt);
            if constexpr (SP2) {
            PG8_LDB(B0, 0, 0); PG8_LDB(B1, 0, 1); PG8_SCHED; PG8_LDA(At, 0, 0); PG8_STAGE(PG8_SA(1, 1), a1 + hstep, voffA);
            PG8_WAIT_V(8); PG8_WAIT_L(0); PG8_BAR; PG8_MMA(0, 0, At, B0); PG8_MMA(0, 1, At, B1); PG8_BAR; PG8_SCHED;
            PG8_LDA(At, 0, 1); PG8_STAGE(PG8_SB(0, 0), b2, voffB); PG8_STAGE(PG8_SB(0, 1), b2 + hstep, voffB); PG8_STAGE(PG8_SA(0, 0), a2, voffA);
            PG8_WAIT_V(8); PG8_WAIT_L(0); PG8_BAR; PG8_MMA(1, 0, At, B0); PG8_MMA(1, 1, At, B1); PG8_BAR; PG8_SCHED;
            PG8_LDB(B0, 1, 0); PG8_LDB(B1, 1, 1); PG8_SCHED; PG8_LDA(At, 1, 0); PG8_STAGE(PG8_SA(0, 1), a2 + hstep, voffA);
            PG8_WAIT_V(8); PG8_WAIT_L(0); PG8_BAR; PG8_MMA(0, 0, At, B0); PG8_MMA(0, 1, At, B1); PG8_BAR; PG8_SCHED;
            PG8_LDA(At, 1, 1); PG8_STAGE(PG8_SB(1, 0), b3, voffB); PG8_STAGE(PG8_SB(1, 1), b3 + hstep, voffB); PG8_STAGE(PG8_SA(1, 0), a3, voffA);
            PG8_WAIT_V(8); PG8_WAIT_L(0); PG8_BAR; PG8_MMA(1, 0, At, B0); PG8_MMA(1, 1, At, B1); PG8_BAR; PG8_SCHED;
            } else {
            PG8_LDB(B0, 0, 0); PG8_SCHED; PG8_LDA(At, 0, 0); PG8_STAGE(PG8_SA(1, 1), a1 + hstep, voffA);
            PG8_WAIT_L(8); PG8_BAR; PG8_WAIT_L(0); PG8_MMA(0, 0, At, B0); PG8_BAR; PG8_SCHED;
            PG8_LDB(B1, 0, 1); PG8_STAGE(PG8_SB(0, 0), b2, voffB);
            PG8_BAR; PG8_WAIT_L(0); PG8_MMA(0, 1, At, B1); PG8_BAR;
            PG8_LDA(At, 0, 1); PG8_STAGE(PG8_SA(0, 0), a2, voffA);
            PG8_BAR; PG8_WAIT_L(0); PG8_MMA(1, 0, At, B0); PG8_BAR; PG8_SCHED;
            PG8_STAGE(PG8_SB(0, 1), b2 + hstep, voffB);
            PG8_WAIT_V(6); PG8_BAR; PG8_MMA(1, 1, At, B1); PG8_BAR;
            PG8_LDB(B0, 1, 0); PG8_SCHED; PG8_LDA(At, 1, 0); PG8_STAGE(PG8_SA(0, 1), a2 + hstep, voffA);
            PG8_WAIT_L(8); PG8_BAR; PG8_WAIT_L(0); PG8_MMA(0, 0, At, B0); PG8_BAR; PG8_SCHED;
            PG8_LDB(B1, 1, 1); PG8_STAGE(PG8_SB(1, 0), b3, voffB);
            PG8_BAR; PG8_WAIT_L(0); PG8_MMA(0, 1, At, B1); PG8_BAR;
            PG8_LDA(At, 1, 1); PG8_STAGE(PG8_SA(1, 0), a3, voffA);
            PG8_BAR; PG8_WAIT_L(0); PG8_MMA(1, 0, At, B0); PG8_BAR; PG8_SCHED;
            PG8_STAGE(PG8_SB(1, 1), b3 + hstep, voffB);
            PG8_WAIT_V(6); PG8_BAR; PG8_MMA(1, 1, At, B1); PG8_BAR;
            }
        }
        if constexpr (ALIGN_EPI) { if (wr == 0) PG8_BAR; }
        if constexpr (!Epi::AFTER_DRAIN) { E(acc, cur, wr, wc, fr, fq); S.done(cur); }
        if (!has_next) break;
#pragma unroll
        for (int a = 0; a < 2; ++a)
#pragma unroll
            for (int b = 0; b < 2; ++b)
#pragma unroll
                for (int m = 0; m < 4; ++m)
#pragma unroll
                    for (int n = 0; n < 2; ++n) acc[a][b][m][n] = (f32x4){0.f, 0.f, 0.f, 0.f};
        cur = nxt; cA = nA; cB = nB; ++ui;
        if constexpr (ALIGN_EPI) { if (wr == 1) PG8_BAR; }
    }
    PG8_WAIT_V(0);
    if constexpr (!ALIGN_EPI) { if (wr == 0) PG8_BAR; }
    PG8_BAR;
    if constexpr (Epi::AFTER_DRAIN) { E.fused(acc, cur, wr, wc, fr, fq, lds, wid, lane); S.done(cur); }
#undef PG8_SA
#undef PG8_SB
#undef PG8_STAGE
#undef PG8_LDA
#undef PG8_LDB
#undef PG8_MMA
#undef PG8_WAIT_V
#undef PG8_WAIT_L
#undef PG8_BAR
#undef PG8_SCHED
}
}

#define XB_TMO      128
#define XB_XCNT(j)  (256  + 64 * (j))
#define XB_XSUB(j)  (1280 + 64 * (j))
#define XB_XGEN(j)  (2304 + 64 * (j))
#define XB_TOP      3328
#define XB_TOPGEN   3392
#define XCD_BAR_WORDS 3456
#define XB_SPIN_CAP (1u << 18)
#define LAS __attribute__((address_space(3)))
__device__ __forceinline__ unsigned xb_ld(unsigned* p)              { return __hip_atomic_load(p, __ATOMIC_RELAXED, __HIP_MEMORY_SCOPE_AGENT); }
__device__ __forceinline__ unsigned xb_add(unsigned* p, unsigned v) { return __hip_atomic_fetch_add(p, v, __ATOMIC_RELAXED, __HIP_MEMORY_SCOPE_AGENT); }
__device__ __forceinline__ unsigned xb_xcc_id() { return (unsigned)__builtin_amdgcn_s_getreg((3 << 11) | 20) & 0xFu; }
#define XB_SPIN(cond, bar) do { unsigned _sp = 0; while (cond) { __builtin_amdgcn_s_sleep(1); \
    if ((++_sp & 255u) == 0u) { if (xb_ld(&(bar)[XB_TMO])) break; if (_sp > XB_SPIN_CAP) { atomicAdd(&(bar)[XB_TMO], 1u); break; } } } } while (0)
struct XcdBarrier { unsigned* bar; unsigned x; volatile LAS unsigned* st; };
__device__ __forceinline__ XcdBarrier xcd_barrier_post(unsigned* bar, volatile LAS unsigned* st) {
    XcdBarrier b; b.bar = bar; b.x = xb_xcc_id(); b.st = st;
    if (threadIdx.x == 0) (void)xb_add(&bar[XB_XCNT(b.x)], 1u);
    return b;
}
__device__ __forceinline__ void xcd_barrier_complete(unsigned* bar, unsigned x, unsigned& nloc, unsigned& nx) {
    const unsigned G = gridDim.x * gridDim.y * gridDim.z;
    unsigned sum, cnt, mine, sp = 0u;
    for (;;) {
        sum = 0u; cnt = 0u; mine = 0u;
#pragma unroll
        for (unsigned j = 0; j < 16; ++j) { const unsigned c = xb_ld(&bar[XB_XCNT(j)]); sum += c; cnt += (c > 0u) ? 1u : 0u; mine = (j == x) ? c : mine; }
        if (sum == G) break;
        __builtin_amdgcn_s_sleep(1);
        if ((++sp & 255u) == 0u) { if (xb_ld(&bar[XB_TMO])) break; if (sp > XB_SPIN_CAP) { atomicAdd(&bar[XB_TMO], 1u); break; } }
    }
    nloc = mine > 0u ? mine : 1u; nx = cnt > 0u ? cnt : 1u;
}
__device__ __forceinline__ void xcd_barrier(const XcdBarrier& b) {
    asm volatile("s_waitcnt vmcnt(0)" ::: "memory");
    __syncthreads();
    if (threadIdx.x == 0) {
        unsigned* bar = b.bar;
        __builtin_amdgcn_s_waitcnt(0);
        unsigned nloc = b.st[0], nx = b.st[1];
        if (nloc == 0u) { xcd_barrier_complete(bar, b.x, nloc, nx); b.st[0] = nloc; b.st[1] = nx; }
        const unsigned old = xb_add(&bar[XB_XSUB(b.x)], 1u);
        const unsigned gen = old / nloc;
        if (old + 1u == (gen + 1u) * nloc) {
            __builtin_amdgcn_fence(__ATOMIC_RELEASE, "agent");
            asm volatile("s_waitcnt vmcnt(0)" ::: "memory");
            const unsigned og = xb_add(&bar[XB_TOP], 1u);
            const unsigned tg = og / nx;
            if (og + 1u == (tg + 1u) * nx) xb_add(&bar[XB_TOPGEN], 1u);
            else XB_SPIN(xb_ld(&bar[XB_TOPGEN]) == tg, bar);
            __builtin_amdgcn_fence(__ATOMIC_ACQUIRE, "agent");
            xb_add(&bar[XB_XGEN(b.x)], 1u);
            asm volatile("s_waitcnt vmcnt(0)" ::: "memory");
        } else {
            XB_SPIN(xb_ld(&bar[XB_XGEN(b.x)]) == gen, bar);
            __builtin_amdgcn_fence(__ATOMIC_ACQUIRE, "agent");
            asm volatile("s_waitcnt vmcnt(0)" ::: "memory");
        }
    }
    __syncthreads();
}

#ifndef PROBE
#define PROBE 0
#endif

typedef pg8::bf16_t bf16_t;
typedef pg8::bf16x8 bf16x8;
typedef pg8::f32x4 f32x4;
typedef pg8::u32x4 u32x4;
typedef unsigned u32x2 __attribute__((ext_vector_type(2)));
typedef float f32x2 __attribute__((ext_vector_type(2)));
using pg8::cvt_pk_bf16; using pg8::sigm;

constexpr int D = 1024, SEQ = 2048, NB = 8, M = 16384, WL = 1536;
static_assert(M == pg8::MROWS, "rows");
constexpr size_t MB = 1024 * 1024;
constexpr size_t WS_CTL = 0;
constexpr size_t WS_SSQ = 64 * 1024;
constexpr size_t WS_CARRY = WS_SSQ + 1 * MB;
constexpr size_t WS_WINE = WS_CARRY + 13 * MB;
constexpr size_t WS_WOUTE = WS_WINE + 20 * MB;
constexpr size_t WS_WINO = WS_WOUTE + 8 * MB;
constexpr size_t WS_WOUTO = WS_WINO + 12 * MB;
constexpr size_t WS_POOLT = WS_WOUTO + 6 * MB;
constexpr size_t WS_RGT = WS_POOLT + 1 * MB;
constexpr size_t WS_IGT = WS_RGT + 768 * 1024;
constexpr size_t WS_HB = WS_IGT + 768 * 1024;
constexpr size_t WS_ACT = WS_HB + 32 * MB;
constexpr size_t WS_END = WS_ACT + 128 * MB;
constexpr int RING_BYTES = 131072, CTL_OFF = RING_BYTES, LDS_BYTES = 147456;
constexpr unsigned CW_TMO2 = 15000;

struct Params {
    const float *x, *norm_even, *w_in_even, *conv_a_w, *conv_a_b, *ln_a_g, *ln_a_b, *pool_w, *pool_b, *pool_scale, *w_out_even,
                *norm_odd, *w_in_odd, *conv_c_w, *conv_c_b, *w_rg, *b_rg, *w_ig, *b_ig, *lru_lambda, *w_out_odd, *final_norm;
    float* out; unsigned char* ws;
};

__device__ __forceinline__ float wave_sum(float v) {
#pragma unroll
    for (int o = 1; o < 64; o <<= 1) v += __shfl_xor(v, o);
    return v;
}
__device__ __forceinline__ void lds_barrier() { asm volatile("s_waitcnt lgkmcnt(0)\n\ts_barrier" ::: "memory"); }
__device__ __forceinline__ float bf_lo(unsigned w) { return __uint_as_float(w << 16); }
__device__ __forceinline__ float bf_hi(unsigned w) { return __uint_as_float(w & 0xffff0000u); }

__device__ __forceinline__ void p0_item(const float* W, int K, int N, bf16_t* WT, const float* scale, int glu, float* scr, int item, int lane) {
    const int nblk = N / 32, kb = item / nblk, nb = item % nblk, k0 = 64 * kb, n0 = 32 * nb;
    int drow0 = n0;
    if (glu && n0 < 2048) { const int bj = n0 >> 10, cc = n0 & 1023; drow0 = 256 * (cc >> 7) + 128 * bj + (cc & 127); }
    float tv[32];
#pragma unroll
    for (int i = 0; i < 32; ++i) { const int kk = 2 * i + (lane >> 5); tv[i] = W[(size_t)(k0 + kk) * N + n0 + (lane & 31)]; }
    if (scale) {
#pragma unroll
        for (int i = 0; i < 32; ++i) tv[i] *= scale[k0 + 2 * i + (lane >> 5)]; }
#pragma unroll
    for (int i = 0; i < 32; ++i) scr[(2 * i + (lane >> 5)) * 33 + (lane & 31)] = tv[i];
    asm volatile("s_waitcnt lgkmcnt(0)" ::: "memory");
    const int c = lane & 7;
#pragma unroll
    for (int j = 0; j < 4; ++j) { const int n = (lane >> 3) + 8 * j; const float* s = scr + (8 * c) * 33 + n;
        u32x4 o; o.x = cvt_pk_bf16(s[0 * 33], s[1 * 33]); o.y = cvt_pk_bf16(s[2 * 33], s[3 * 33]); o.z = cvt_pk_bf16(s[4 * 33], s[5 * 33]); o.w = cvt_pk_bf16(s[6 * 33], s[7 * 33]);
        *(u32x4*)(WT + (size_t)(drow0 + n) * K + k0 + 8 * c) = o; }
    asm volatile("s_waitcnt lgkmcnt(0)" ::: "memory");
}
__device__ __forceinline__ void p0_prologue(const Params& p, unsigned char* lds, int wave, int lane) {
    float* scr = (float*)(lds + wave * 16384);
    const int gw = blockIdx.x * 8 + wave, NGW = gridDim.x * 8;
    unsigned char* ws = p.ws;
    constexpr int I_WINE = 16 * 160, I_WOUTE = 32 * 32, I_WINO = 16 * 96, I_WOUTO = 24 * 32, I_POOL = 4 * 8, I_G = 2 * 4;
    constexpr int NITEMS = 2 * (I_WINE + I_WOUTE + I_WINO + I_WOUTO) + 8 * I_POOL + 48 * I_G;
    for (int it = gw; it < NITEMS; it += NGW) {
        int r = it;
        if (r < 2 * I_WINE) { const int j = r / I_WINE; p0_item(p.w_in_even + (size_t)j * 1024 * 5120, 1024, 5120, (bf16_t*)(ws + WS_WINE) + (size_t)j * 5120 * 1024, p.norm_even + j * 1024, 1, scr, r % I_WINE, lane); continue; } r -= 2 * I_WINE;
        if (r < 2 * I_WOUTE) { const int j = r / I_WOUTE; p0_item(p.w_out_even + (size_t)j * 2048 * 1024, 2048, 1024, (bf16_t*)(ws + WS_WOUTE) + (size_t)j * 1024 * 2048, nullptr, 0, scr, r % I_WOUTE, lane); continue; } r -= 2 * I_WOUTE;
        if (r < 2 * I_WINO) { const int j = r / I_WINO; p0_item(p.w_in_odd + (size_t)j * 1024 * 3072, 1024, 3072, (bf16_t*)(ws + WS_WINO) + (size_t)j * 3072 * 1024, p.norm_odd + j * 1024, 0, scr, r % I_WINO, lane); continue; } r -= 2 * I_WINO;
        if (r < 2 * I_WOUTO) { const int j = r / I_WOUTO; p0_item(p.w_out_odd + (size_t)j * 1536 * 1024, 1536, 1024, (bf16_t*)(ws + WS_WOUTO) + (size_t)j * 1024 * 1536, nullptr, 0, scr, r % I_WOUTO, lane); continue; } r -= 2 * I_WOUTO;
        if (r < 8 * I_POOL) { const int j = r / I_POOL; p0_item(p.pool_w + (size_t)j * 65536, 256, 256, (bf16_t*)(ws + WS_POOLT) + (size_t)j * 65536, nullptr, 0, scr, r % I_POOL, lane); continue; } r -= 8 * I_POOL;
        if (r < 24 * I_G) { const int j = r / I_G; p0_item(p.w_rg + (size_t)j * 16384, 128, 128, (bf16_t*)(ws + WS_RGT) + (size_t)j * 16384, nullptr, 0, scr, r % I_G, lane); continue; } r -= 24 * I_G;
        { const int j = r / I_G; p0_item(p.w_ig + (size_t)j * 16384, 128, 128, (bf16_t*)(ws + WS_IGT) + (size_t)j * 16384, nullptr, 0, scr, r % I_G, lane); }
    }
    bf16_t* HB = (bf16_t*)(ws + WS_HB); float* ssq = (float*)(ws + WS_SSQ);
    for (int m0 = 4 * gw; m0 < M; m0 += 4 * NGW) {
        f32x4 v[4][4]; float s[4];
#pragma unroll
        for (int h = 0; h < 4; ++h) { const f32x4* xr = (const f32x4*)(p.x + (size_t)(m0 + h) * D) + lane;
#pragma unroll
            for (int j = 0; j < 4; ++j) v[h][j] = xr[64 * j]; }
#pragma unroll
        for (int h = 0; h < 4; ++h) { float a = 0.f;
#pragma unroll
            for (int j = 0; j < 4; ++j) a += (v[h][j][0] * v[h][j][0] + v[h][j][1] * v[h][j][1]) + (v[h][j][2] * v[h][j][2] + v[h][j][3] * v[h][j][3]);
            s[h] = a; }
#pragma unroll
        for (int o = 1; o < 64; o <<= 1) { s[0] += __shfl_xor(s[0], o); s[1] += __shfl_xor(s[1], o); s[2] += __shfl_xor(s[2], o); s[3] += __shfl_xor(s[3], o); }
#pragma unroll
        for (int h = 0; h < 4; ++h) { u32x2* o8 = (u32x2*)(HB + (size_t)(m0 + h) * D) + lane;
#pragma unroll
            for (int j = 0; j < 4; ++j) { u32x2 w; w.x = cvt_pk_bf16(v[h][j][0], v[h][j][1]); w.y = cvt_pk_bf16(v[h][j][2], v[h][j][3]); o8[64 * j] = w; }
            if (lane < 16) ssq[(size_t)lane * M + m0 + h] = (lane == 0) ? s[h] : 0.f; }
    }
    unsigned long long* cg = (unsigned long long*)(ws + WS_CARRY);
    for (size_t i = (size_t)blockIdx.x * 512 + threadIdx.x; i < (size_t)4 * 16 * 96 * 128; i += (size_t)gridDim.x * 512) cg[i] = 0ull;
}

#define CONV_TILE(k) ((int)(blockIdx.x & 7) * 128 + (int)(blockIdx.x >> 3) + 32 * (k))
__device__ __forceinline__ void e2_conv_phase(const Params& p, unsigned char* lds, int j, int tid, int wave, int lane, const bool dummy) {
    const bf16_t* U = (const bf16_t*)(p.ws + WS_ACT); const bf16_t* S = (const bf16_t*)(p.ws + WS_ACT + 64 * MB); bf16_t* W0 = dummy ? (bf16_t*)p.out - WS_HB / 2 : (bf16_t*)p.ws;
    const int c0 = 2 * tid;
    float* convo = (float*)lds;
    f32x2 w[31];
    { const float* cw = p.conv_a_w + (size_t)j * 31 * 1024 + c0;
#pragma unroll
      for (int k = 0; k < 31; ++k) w[k] = *(const f32x2*)(cw + k * 1024); }
    const f32x2 bias = *(const f32x2*)(p.conv_a_b + j * 1024 + c0);
    const float* lg = p.ln_a_g + j * 1024; const float* lb = p.ln_a_b + j * 1024;
#pragma unroll 1
    for (int k_ = 0; k_ < 4; ++k_) {
        const int tile = CONV_TILE(k_), b = tile >> 7, tt0 = (tile & 127) * 16;
        unsigned xr[46];
        { const __attribute__((address_space(1))) bf16_t* pr = (const __attribute__((address_space(1))) bf16_t*)U + ((long)b * SEQ + tt0 - 30) * 1024 + c0;
#pragma unroll
          for (int r = 0; r < 46; ++r) { const int t = tt0 - 30 + r; xr[r] = 0u; if (t >= 0) xr[r] = *(const __attribute__((address_space(1))) unsigned*)pr; pr += 1024; asm volatile("" : "+v"(pr)); } }
        const size_t row0 = (size_t)b * SEQ + tt0 + 2 * wave;
        u32x2 sw[2][4];
#pragma unroll
        for (int q = 0; q < 2; ++q)
#pragma unroll
            for (int jj = 0; jj < 4; ++jj) sw[q][jj] = *(const u32x2*)(S + (row0 + q) * 2048 + 4 * lane + 256 * jj);
#pragma unroll
        for (int i = 0; i < 16; ++i) { f32x2 a = bias;
#pragma unroll
            for (int k = 0; k < 31; ++k) a += w[k] * (f32x2){bf_lo(xr[i + k]), bf_hi(xr[i + k])};
            *(f32x2*)(convo + i * 1024 + c0) = a; }
        lds_barrier();
        f32x4 v[2][4]; float s[2], s2[2];
#pragma unroll
        for (int q = 0; q < 2; ++q) { s[q] = 0.f;
#pragma unroll
            for (int jj = 0; jj < 4; ++jj) { v[q][jj] = *(const f32x4*)(convo + (2 * wave + q) * 1024 + 4 * lane + 256 * jj); s[q] += (v[q][jj][0] + v[q][jj][1]) + (v[q][jj][2] + v[q][jj][3]); } }
#pragma unroll
        for (int o = 1; o < 64; o <<= 1) { s[0] += __shfl_xor(s[0], o); s[1] += __shfl_xor(s[1], o); }
#pragma unroll
        for (int q = 0; q < 2; ++q) { const float mean = s[q] * (1.0f / 1024.0f); s2[q] = 0.f;
#pragma unroll
            for (int jj = 0; jj < 4; ++jj) { v[q][jj] = v[q][jj] - mean; s2[q] += (v[q][jj][0] * v[q][jj][0] + v[q][jj][1] * v[q][jj][1]) + (v[q][jj][2] * v[q][jj][2] + v[q][jj][3] * v[q][jj][3]); } }
#pragma unroll
        for (int o = 1; o < 64; o <<= 1) { s2[0] += __shfl_xor(s2[0], o); s2[1] += __shfl_xor(s2[1], o); }
#pragma unroll
        for (int jj = 0; jj < 4; ++jj) { const int c = 4 * lane + 256 * jj; const f32x4 g = *(const f32x4*)(lg + c), be = *(const f32x4*)(lb + c);
#pragma unroll
            for (int q = 0; q < 2; ++q) { const float rstd = rsqrtf(s2[q] * (1.0f / 1024.0f) + 1e-5f); float o[4];
                const float sa[4] = {bf_lo(sw[q][jj].x), bf_hi(sw[q][jj].x), bf_lo(sw[q][jj].y), bf_hi(sw[q][jj].y)};
#pragma unroll
                for (int e = 0; e < 4; ++e) { const float y = v[q][jj][e] * rstd * g[e] + be[e]; o[e] = y * sigm(y) * sa[e]; }
                u32x2 ow; ow.x = cvt_pk_bf16(o[0], o[1]); ow.y = cvt_pk_bf16(o[2], o[3]);
                const size_t oo = dummy ? WS_HB / 2 + (row0 + q) * 1024 + c : (WS_ACT + 64 * MB) / 2 + (row0 + q) * 2048 + c; *(u32x2*)(W0 + oo) = ow; } }
        lds_barrier();
    }
}

template <int W>
__device__ __forceinline__ void pool_load(const bf16_t* BV, int b, int tt0, int g, int wave, int lane, bool live, u32x2 (&raw)[8 + W - 1]) {
    const bf16_t* src = BV + (size_t)b * SEQ * 1024 + 256 * g + 4 * lane;
#pragma unroll
    for (int r = 0; r < 8 + W - 1; ++r) { const int t = tt0 + 8 * wave - (W - 1) + r; raw[r] = (u32x2){0u, 0u}; if (live && t >= 0) raw[r] = *(const u32x2*)(src + (size_t)t * 1024); }
}
template <int W>
__device__ __forceinline__ void pool_rows(const u32x2 (&raw)[8 + W - 1], unsigned char* dl, int tt0, int wave, int lane) {
    f32x4 x[8 + W - 1];
#pragma unroll
    for (int r = 0; r < 8 + W - 1; ++r) x[r] = (f32x4){bf_lo(raw[r].x), bf_hi(raw[r].x), bf_lo(raw[r].y), bf_hi(raw[r].y)};
#pragma unroll
    for (int i = 0; i < 8; ++i) { const int t = tt0 + 8 * wave + i; f32x4 s = x[i];
#pragma unroll
        for (int jj = 1; jj < W; ++jj) s += x[i + jj];
        const float inv = 1.0f / (float)((t + 1) < W ? (t + 1) : W);
        const f32x4 d = s * inv - x[i + W - 1];
        u32x2 o; o.x = cvt_pk_bf16(d[0], d[1]); o.y = cvt_pk_bf16(d[2], d[3]);
        *(u32x2*)(dl + (8 * wave + i) * 528 + lane * 8) = o; }
}
template <int W>
__device__ __forceinline__ void e2_pool_phase(const Params& p, unsigned char* lds, int j, int g, int wave, int lane, const bool dummy) {
    const bf16_t* BV = (const bf16_t*)(p.ws + WS_ACT + 32 * MB); const bf16_t* S = (const bf16_t*)(p.ws + WS_ACT + 64 * MB); bf16_t* W0 = dummy ? (bf16_t*)p.out - WS_HB / 2 : (bf16_t*)p.ws;
    unsigned char* dl = lds;
    const int c = lane & 15, q = lane >> 4, e0 = 32 * wave;
    const bf16_t* Bt = (const bf16_t*)(p.ws + WS_POOLT) + (size_t)(j * 4 + g) * 65536;
    bf16x8 Bf[2][8];
#pragma unroll
    for (int nt = 0; nt < 2; ++nt)
#pragma unroll
        for (int ks = 0; ks < 8; ++ks) Bf[nt][ks] = *(const bf16x8*)(Bt + (size_t)(e0 + 16 * nt + c) * 256 + 32 * ks + 8 * q);
    f32x4 pb[2], ps[2];
#pragma unroll
    for (int nt = 0; nt < 2; ++nt) { const int ch = 256 * g + e0 + 16 * nt + 4 * q; pb[nt] = *(const f32x4*)(p.pool_b + j * 1024 + ch); ps[nt] = *(const f32x4*)(p.pool_scale + j * 1024 + ch); }
    const int b = blockIdx.x & 7, l2 = (int)(blockIdx.x >> 3) >> 2;
    constexpr bool PF = (W <= 8);
    u32x2 raw[PF ? 8 + W - 1 : 1];
    if constexpr (PF) pool_load<W>(BV, b, l2 * 64, g, wave, lane, true, raw);
#pragma unroll 1
    for (int k_ = 0; k_ < 4; ++k_) {
        const int tt0 = (l2 + 8 * k_) * 64;
        u32x2 rawN[PF ? 8 + W - 1 : 1], rawL[PF ? 1 : 8 + W - 1];
        if constexpr (PF) pool_load<W>(BV, b, (l2 + 8 * (k_ + 1)) * 64, g, wave, lane, k_ < 3, rawN);
        else pool_load<W>(BV, b, tt0, g, wave, lane, true, rawL);
        u32x2 sbw[4][2];
#pragma unroll
        for (int mt = 0; mt < 4; ++mt)
#pragma unroll
            for (int nt = 0; nt < 2; ++nt) sbw[mt][nt] = *(const u32x2*)(S + ((size_t)b * SEQ + tt0 + 16 * mt + c) * 2048 + 1024 + 256 * g + e0 + 16 * nt + 4 * q);
        if constexpr (PF) pool_rows<W>(raw, dl, tt0, wave, lane); else pool_rows<W>(rawL, dl, tt0, wave, lane);
        lds_barrier();
#pragma unroll
        for (int mt = 0; mt < 4; ++mt) {
            bf16x8 Af[8];
#pragma unroll
            for (int ks = 0; ks < 8; ++ks) Af[ks] = *(const bf16x8*)(dl + (16 * mt + c) * 528 + (32 * ks + 8 * q) * 2);
            f32x4 acc[2] = {(f32x4){0.f, 0.f, 0.f, 0.f}, (f32x4){0.f, 0.f, 0.f, 0.f}};
#pragma unroll
            for (int ks = 0; ks < 8; ++ks)
#pragma unroll
                for (int nt = 0; nt < 2; ++nt) acc[nt] = __builtin_amdgcn_mfma_f32_16x16x32_bf16(Bf[nt][ks], Af[ks], acc[nt], 0, 0, 0);
            const size_t row = (size_t)b * SEQ + tt0 + 16 * mt + c;
#pragma unroll
            for (int nt = 0; nt < 2; ++nt) { const int ch = 256 * g + e0 + 16 * nt + 4 * q; const u32x2 sw = sbw[mt][nt];
                const float sb[4] = {bf_lo(sw.x), bf_hi(sw.x), bf_lo(sw.y), bf_hi(sw.y)}; float o[4];
#pragma unroll
                for (int e = 0; e < 4; ++e) o[e] = (acc[nt][e] + pb[nt][e]) * ps[nt][e] * sb[e];
                u32x2 ow; ow.x = cvt_pk_bf16(o[0], o[1]); ow.y = cvt_pk_bf16(o[2], o[3]);
                const size_t oo = dummy ? WS_HB / 2 + row * 1024 + ch : (WS_ACT + 64 * MB) / 2 + row * 2048 + 1024 + ch; *(u32x2*)(W0 + oo) = ow; }
        }
        lds_barrier();
        if constexpr (PF) {
#pragma unroll
            for (int r = 0; r < 8 + W - 1; ++r) raw[r] = rawN[r]; }
    }
}

#define O2_TILE(k) ((int)(blockIdx.x & 7) * 192 + (int)(blockIdx.x >> 3) + 32 * (k))
#define O2_HEAD_CONSTS(IDX) do { const int id_ = (IDX), hd_ = (id_ % 192) % 12, jch_ = 16 * wave + c, ch_ = hd_ * 128 + jch_; \
        const bf16_t* RGT_ = (const bf16_t*)(p.ws + WS_RGT) + (size_t)(j * 12 + hd_) * 16384 + (size_t)jch_ * 128 + 8 * q; \
        const bf16_t* IGT_ = (const bf16_t*)(p.ws + WS_IGT) + (size_t)(j * 12 + hd_) * 16384 + (size_t)jch_ * 128 + 8 * q; \
        _Pragma("unroll") for (int ks = 0; ks < 4; ++ks) { Br[ks] = *(const bf16x8*)(RGT_ + 32 * ks); Bi[ks] = *(const bf16x8*)(IGT_ + 32 * ks); } \
        brg = p.b_rg[j * WL + ch_]; big = p.b_ig[j * WL + ch_]; lam = p.lru_lambda[j * WL + ch_]; \
        _Pragma("unroll") for (int k = 0; k < 4; ++k) cw[k] = *(const f32x4*)(p.conv_c_w + (size_t)(j * 4 + k) * WL + hd_ * 128 + c4); \
        cb = *(const f32x4*)(p.conv_c_b + j * WL + hd_ * 128 + c4); } while (0)
__device__ __forceinline__ void o2_phase(const Params& p, unsigned char* lds, int j, int tid, int wave, int lane, const bool dummy) {
    const bf16_t* XR = (const bf16_t*)(p.ws + WS_ACT); const bf16_t* SG = (const bf16_t*)(p.ws + WS_ACT + 48 * MB); bf16_t* W0 = dummy ? (bf16_t*)p.out - WS_HB / 2 : (bf16_t*)p.ws;
    float* XCF = (float*)lds;
    bf16_t* XCB = (bf16_t*)(lds + 128 * 528);
    const int c = lane & 15, q = lane >> 4;
    const int c4 = (lane & 31) * 4, tok0 = 16 * wave + 8 * (lane >> 5);
    const int oc4 = 16 * wave + (lane & 3) * 4, orow = lane >> 2;
    u32x2 xw[11], sgv[8];
    bf16x8 Br[4], Bi[4]; float brg, big, lam; f32x4 cw[4], cb;
    O2_HEAD_CONSTS(O2_TILE(0));
    { const int id = O2_TILE(0), b = id / 192, u_ = id % 192, chunk = u_ / 12, hd = u_ % 12, t0 = chunk * 128, chb = hd * 128;
      const bf16_t* src = XR + (size_t)b * SEQ * WL + chb + c4;
#pragma unroll
      for (int r = 0; r < 11; ++r) { const int t = t0 + tok0 - 3 + r; xw[r] = *(const u32x2*)(src + (size_t)(t < 0 ? 0 : t) * WL); }
      const size_t obase = ((size_t)b * SEQ + t0 + orow) * WL + chb + oc4;
#pragma unroll
      for (int k = 0; k < 8; ++k) sgv[k] = *(const u32x2*)(SG + obase + (size_t)(16 * k) * WL); }
#pragma unroll 1
    for (int k_ = 0; k_ < 6; ++k_) {
        const int id = O2_TILE(k_), b = id / 192, u_ = id % 192, chunk = u_ / 12, hd = u_ % 12, bh = b * 12 + hd, t0 = chunk * 128, chb = hd * 128;
        const int jch = 16 * wave + c, ch = chb + jch;
        {
            f32x4 xv[11];
#pragma unroll
            for (int r = 0; r < 11; ++r) { const bool in = (t0 + tok0 - 3 + r) >= 0; xv[r] = in ? (f32x4){bf_lo(xw[r].x), bf_hi(xw[r].x), bf_lo(xw[r].y), bf_hi(xw[r].y)} : (f32x4){0.f, 0.f, 0.f, 0.f}; }
#pragma unroll
            for (int i = 0; i < 8; ++i) { f32x4 v = cb;
#pragma unroll
                for (int k = 0; k < 4; ++k) v += cw[k] * xv[i + k];
                *(f32x4*)(XCF + (tok0 + i) * 132 + c4) = v;
                u32x2 o; o.x = cvt_pk_bf16(v[0], v[1]); o.y = cvt_pk_bf16(v[2], v[3]); *(u32x2*)(XCB + (tok0 + i) * 136 + c4) = o; }
        }
        lds_barrier();
        const float e_ = __expf(-lam); const float sp8 = 8.0f * (e_ < 0.0625f ? e_ * (1.0f - e_ * (0.5f - e_ * ((1.0f / 3.0f) - e_ * (0.25f - e_ * 0.2f)))) : __logf(1.0f + e_));
#pragma unroll
        for (int ks = 0; ks < 4; ++ks) asm volatile("" :: "v"(Br[ks]), "v"(Bi[ks]));
        asm volatile("" :: "v"(brg), "v"(big), "v"(sp8));
        { const int idN = O2_TILE(k_ < 5 ? k_ + 1 : k_), bN = idN / 192, uN = idN % 192, chunkN = uN / 12, hdN = uN % 12, t0N = chunkN * 128, chbN = hdN * 128;
          const bf16_t* src = XR + (size_t)bN * SEQ * WL + chbN + c4;
#pragma unroll
          for (int r = 0; r < 11; ++r) { const int t = t0N + tok0 - 3 + r; xw[r] = *(const u32x2*)(src + (size_t)(t < 0 ? 0 : t) * WL); }
        }
        float hz[8][4], pt[8][4];
        float Cz = 0.f, Pc = 1.f;
        if ((PROBE & 64) && dummy) {
#pragma unroll
            for (int s = 0; s < 8; ++s)
#pragma unroll
                for (int i = 0; i < 4; ++i) { hz[s][i] = 0.f; pt[s][i] = 1.f; } }
        else {
#define O2_GATES(S_, R_, I_) do { bf16x8 Af_[4]; \
            _Pragma("unroll") for (int ks = 0; ks < 4; ++ks) Af_[ks] = *(const bf16x8*)(XCB + (16 * (S_) + c) * 136 + 32 * ks + 8 * q); \
            R_ = (f32x4){0.f, 0.f, 0.f, 0.f}; I_ = (f32x4){0.f, 0.f, 0.f, 0.f}; \
            _Pragma("unroll") for (int ks = 0; ks < 4; ++ks) { R_ = __builtin_amdgcn_mfma_f32_16x16x32_bf16(Af_[ks], Br[ks], R_, 0, 0, 0); I_ = __builtin_amdgcn_mfma_f32_16x16x32_bf16(Af_[ks], Bi[ks], I_, 0, 0, 0); } } while (0)
        f32x4 aRn, aIn;
        O2_GATES(0, aRn, aIn);
#pragma unroll
        for (int s = 0; s < 8; ++s) {
            const f32x4 aR = aRn, aI = aIn;
            if (s < 7) O2_GATES(s + 1, aRn, aIn);
            float ph = 0.f, pp = 1.f, hl[4], pl[4];
            float av[4], bv[4];
#pragma unroll
            for (int h2 = 0; h2 < 2; ++h2) {
                const f32x2 xc = (f32x2){XCF[(16 * s + 4 * q + 2 * h2) * 132 + jch], XCF[(16 * s + 4 * q + 2 * h2 + 1) * 132 + jch]};
                const f32x2 zr = ((f32x2){aR[2 * h2], aR[2 * h2 + 1]} + brg) * (-1.44269504f), zi = ((f32x2){aI[2 * h2], aI[2 * h2 + 1]} + big) * (-1.44269504f);
                f32x2 er, ei; er.x = __builtin_amdgcn_exp2f(zr.x); er.y = __builtin_amdgcn_exp2f(zr.y); ei.x = __builtin_amdgcn_exp2f(zi.x); ei.y = __builtin_amdgcn_exp2f(zi.y);
                const f32x2 dr = er + 1.0f, di = ei + 1.0f;
                f32x2 r, ig; r.x = __builtin_amdgcn_rcpf(dr.x); r.y = __builtin_amdgcn_rcpf(dr.y); ig.x = __builtin_amdgcn_rcpf(di.x); ig.y = __builtin_amdgcn_rcpf(di.y);
                const f32x2 x2 = r * (2.0f * sp8), la2 = r * (-1.44269504f * sp8);
                f32x2 a; a.x = __builtin_amdgcn_exp2f(la2.x); a.y = __builtin_amdgcn_exp2f(la2.y);
                const f32x2 ser = x2 * (1.0f - x2 * (0.5f - x2 * (1.0f / 6.0f))), dir = 1.0f - a * a;
                f32x2 om; om.x = x2.x < 0.015625f ? ser.x : dir.x; om.y = x2.y < 0.015625f ? ser.y : dir.y;
                f32x2 sq; sq.x = __builtin_amdgcn_sqrtf(om.x); sq.y = __builtin_amdgcn_sqrtf(om.y);
                const f32x2 bt = sq * (ig * xc);
                av[2 * h2] = a.x; av[2 * h2 + 1] = a.y; bv[2 * h2] = bt.x; bv[2 * h2 + 1] = bt.y;
            }
#pragma unroll
            for (int i = 0; i < 4; ++i) { ph = av[i] * ph + bv[i]; pp = pp * av[i]; hl[i] = ph; pl[i] = pp; }
            float P4 = pp, H4 = ph;
            { const float Pp = __shfl_up(P4, 16), Hp = __shfl_up(H4, 16); if (q >= 1) { H4 = P4 * Hp + H4; P4 = P4 * Pp; } }
            { const float Pp = __shfl_up(P4, 32), Hp = __shfl_up(H4, 32); if (q >= 2) { H4 = P4 * Hp + H4; P4 = P4 * Pp; } }
            float Pe = __shfl_up(P4, 16), He = __shfl_up(H4, 16); if (q == 0) { Pe = 1.f; He = 0.f; }
            const float Pt = __shfl(P4, 48 + c), Ht = __shfl(H4, 48 + c);
            const float Hs = Pe * Cz + He, Ps = Pe * Pc;
#pragma unroll
            for (int i = 0; i < 4; ++i) { hz[s][i] = hl[i] + pl[i] * Hs; pt[s][i] = pl[i] * Ps; }
            Cz = Pt * Cz + Ht; Pc = Pt * Pc;
        }
#undef O2_GATES
        }
        unsigned long long* slots = (unsigned long long*)(p.ws + WS_CARRY) + ((size_t)((dummy ? j + 2 : j) * 16) * 96 + bh) * 128 + jch;
        if (chunk < 15 && q == 0)
            __hip_atomic_store(slots + (size_t)chunk * 96 * 128, ((unsigned long long)(__float_as_uint(Pc) | 0x80000000u) << 32) | (unsigned long long)__float_as_uint(Cz), __ATOMIC_RELAXED, __HIP_MEMORY_SCOPE_AGENT);
        float Hc = 0.f;
#pragma unroll
        for (int hb_ = 0; hb_ < 2; ++hb_) {
            if (chunk > 8 * hb_) {
                unsigned* tmo = (unsigned*)(p.ws + WS_CTL) + CW_TMO2; unsigned spins = 0u; unsigned long long va[8];
                for (;;) { bool ok = true;
#pragma unroll
                    for (int pc = 0; pc < 8; ++pc) if (8 * hb_ + pc < chunk) va[pc] = __hip_atomic_load(slots + (size_t)(8 * hb_ + pc) * 96 * 128, __ATOMIC_RELAXED, __HIP_MEMORY_SCOPE_AGENT);
#pragma unroll
                    for (int pc = 0; pc < 8; ++pc) if (8 * hb_ + pc < chunk) ok = ok && (((unsigned)(va[pc] >> 32) & 0x80000000u) != 0u);
                    if (__all(ok)) break;
                    __builtin_amdgcn_s_sleep(1);
                    if ((++spins & 255u) == 0u) { if (__hip_atomic_load(tmo, __ATOMIC_RELAXED, __HIP_MEMORY_SCOPE_AGENT) != 0u) break; if (spins > (1u << 19)) { __hip_atomic_store(tmo, 1u, __ATOMIC_RELAXED, __HIP_MEMORY_SCOPE_AGENT); break; } } }
#pragma unroll
                for (int pc = 0; pc < 8; ++pc) if (8 * hb_ + pc < chunk) Hc = __uint_as_float((unsigned)(va[pc] >> 32) & 0x7fffffffu) * Hc + __uint_as_float((unsigned)va[pc]);
            }
        }
        O2_HEAD_CONSTS(O2_TILE(k_ < 5 ? k_ + 1 : k_));
#pragma unroll
        for (int s = 0; s < 8; ++s)
#pragma unroll
            for (int i = 0; i < 4; ++i) XCF[(16 * s + 4 * q + i) * 132 + jch] = hz[s][i] + pt[s][i] * Hc;
        asm volatile("s_waitcnt lgkmcnt(0)" ::: "memory");
        const size_t obase = ((size_t)b * SEQ + t0 + orow) * WL + chb + oc4;
#pragma unroll
        for (int k = 0; k < 8; ++k) { const f32x4 h = *(const f32x4*)(XCF + (orow + 16 * k) * 132 + oc4); const u32x2 g = sgv[k];
            u32x2 ow; ow.x = cvt_pk_bf16(h[0] * bf_lo(g.x), h[1] * bf_hi(g.x)); ow.y = cvt_pk_bf16(h[2] * bf_lo(g.y), h[3] * bf_hi(g.y));
            const size_t oo = dummy ? WS_HB / 2 + ((size_t)b * SEQ + t0 + orow + 16 * k) * 1024 + ((chb + oc4) & 1023) : (WS_ACT + 48 * MB) / 2 + obase + (size_t)(16 * k) * WL;
            *(u32x2*)(W0 + oo) = ow; }
        lds_barrier();
        { const int idN = O2_TILE(k_ < 5 ? k_ + 1 : k_), bN = idN / 192, uN = idN % 192, chunkN = uN / 12, hdN = uN % 12, t0N = chunkN * 128, chbN = hdN * 128;
          const size_t obaseN = ((size_t)bN * SEQ + t0N + orow) * WL + chbN + oc4;
#pragma unroll
          for (int k = 0; k < 8; ++k) sgv[k] = *(const u32x2*)(SG + obaseN + (size_t)(16 * k) * WL); }
    }
}

typedef const __attribute__((address_space(4))) Params* KP;
#define GRID_BAR() do { KP qb_ = kp; asm volatile("" : "+s"(qb_)); XcdBarrier b_; b_.bar = (unsigned*)(qb_->ws + WS_CTL); b_.x = xb_xcc_id(); b_.st = (volatile LAS unsigned*)(ldsl + CTL_OFF); xcd_barrier(b_); } while (0)
#define PHASE_ARGS() KP qk_ = kp; asm volatile("" : "+s"(qk_)); Params pl; { const __attribute__((address_space(4))) unsigned long long* s_ = (const __attribute__((address_space(4))) unsigned long long*)qk_; char** d_ = (char**)&pl; _Pragma("unroll") for (int i_ = 0; i_ < 24; ++i_) d_[i_] = (char*)(__attribute__((address_space(1))) char*)s_[i_]; }     unsigned char* ws = pl.ws; \
    int wv = wave0_; asm volatile("" : "+s"(wv)); unsigned m1_ = ~0u; asm volatile("" : "+s"(m1_)); int ln = (int)__builtin_amdgcn_mbcnt_hi(m1_, __builtin_amdgcn_mbcnt_lo(m1_, 0u)); asm volatile("" : "+v"(ln)); const int tl = wv * 64 + ln; (void)tl; (void)ws
__global__ void __launch_bounds__(512, 2) trunk_fwd(Params p_unused) {
    extern __shared__ __attribute__((aligned(16))) unsigned char lds_raw[];
    LAS unsigned char* ldsl = (LAS unsigned char*)lds_raw;
    const KP kp = (KP)__builtin_amdgcn_kernarg_segment_ptr();
    const int G = gridDim.x;
    const int wave0_ = __builtin_amdgcn_readfirstlane((int)threadIdx.x >> 6);
    { PHASE_ARGS();
      if (tl < 16) ((LAS unsigned*)(ldsl + CTL_OFF))[tl] = 0u;
      __syncthreads();
      (void)xcd_barrier_post((unsigned*)(ws + WS_CTL), (volatile LAS unsigned*)(ldsl + CTL_OFF));
      _Pragma("unroll 1") for (int rep = 0; rep < ((PROBE & 8) ? 2 : 1); ++rep) p0_prologue(pl, lds_raw, wv, ln);
    }
    GRID_BAR();
    if (PROBE & 32) { _Pragma("unroll 1") for (int rep = 0; rep < 8; ++rep) GRID_BAR(); }
#pragma unroll 1
    for (int layer = 0; layer < 4; ++layer) {
        const int j = layer >> 1;
        if ((layer & 1) == 0) {
            { PHASE_ARGS(); float* ssq = (float*)(ws + WS_SSQ); bf16_t* HB = (bf16_t*)(ws + WS_HB);
              pg8::Gemm g{HB, (const bf16_t*)(ws + WS_WINE) + (size_t)j * 5120 * 1024, M, 5120, 1024}; pg8::StaticOrder S; S.init(M, 5120, G, (int)blockIdx.x);
              { const int pm_ = 8 * (int)(blockIdx.x & 7) + (int)((blockIdx.x >> 3) & 7);
                if (tl < 256) { const int row = 256 * pm_ + tl; float sq = 0.f;
                    _Pragma("unroll") for (int q_ = 0; q_ < 16; ++q_) sq += ssq[(size_t)q_ * M + row];
                    ((LAS float*)(ldsl + CTL_OFF + 1024))[tl] = rsqrtf(sq * (1.0f / 1024.0f) + 1e-6f); }
                __syncthreads(); }
              pg8::EpiE1 E{(const LAS float*)(ldsl + CTL_OFF + 1024), (bf16_t*)(ws + WS_ACT)};
              _Pragma("unroll 1") for (int rep = 0; rep < ((PROBE & 1) ? 2 : 1); ++rep) pg8::gemm_phase<pg8::EpiE1, pg8::StaticOrder, true, true>(ldsl, g, S, E, tl); }
            GRID_BAR();
            _Pragma("unroll 1") for (int rep = ((PROBE & 2) ? 0 : 1); rep < 2; ++rep) {
            #ifndef NO_CONV
            { PHASE_ARGS(); e2_conv_phase(pl, lds_raw, j, tl, wv, ln, (PROBE & 2) && rep == 0); }
#endif
#ifndef NO_POOL
            { PHASE_ARGS(); const int g_ = (int)(blockIdx.x >> 3) & 3; const bool dm = (PROBE & 2) && rep == 0;
              if (g_ == 0) e2_pool_phase<2>(pl, lds_raw, j, 0, wv, ln, dm); else if (g_ == 1) e2_pool_phase<4>(pl, lds_raw, j, 1, wv, ln, dm);
              else if (g_ == 2) e2_pool_phase<8>(pl, lds_raw, j, 2, wv, ln, dm); else e2_pool_phase<16>(pl, lds_raw, j, 3, wv, ln, dm); }
#endif
            }
            GRID_BAR();
            { PHASE_ARGS(); float* ssq = (float*)(ws + WS_SSQ); bf16_t* HB = (bf16_t*)(ws + WS_HB);
              pg8::Gemm g{(const bf16_t*)(ws + WS_ACT + 64 * MB), (const bf16_t*)(ws + WS_WOUTE) + (size_t)j * 1024 * 2048, M, 1024, 2048}; pg8::StaticOrder S; S.init(M, 1024, G, (int)blockIdx.x);
              pg8::EpiRes E{HB, ssq};
              _Pragma("unroll 1") for (int rep = 0; rep < (((PROBE & 16) && layer == 0) ? 2 : 1); ++rep) pg8::gemm_phase<pg8::EpiRes, pg8::StaticOrder, true, true>(ldsl, g, S, E, tl); }
            GRID_BAR();
        } else {
            { PHASE_ARGS(); float* ssq = (float*)(ws + WS_SSQ); bf16_t* HB = (bf16_t*)(ws + WS_HB);
              pg8::Gemm g{HB, (const bf16_t*)(ws + WS_WINO) + (size_t)j * 3072 * 1024, M, 3072, 1024}; pg8::StaticOrder S; S.init(M, 3072, G, (int)blockIdx.x);
              { const int pm_ = 8 * (int)(blockIdx.x & 7) + (int)((blockIdx.x >> 3) & 7);
                if (tl < 256) { const int row = 256 * pm_ + tl; float sq = 0.f;
                    _Pragma("unroll") for (int q_ = 0; q_ < 16; ++q_) sq += ssq[(size_t)q_ * M + row];
                    ((LAS float*)(ldsl + CTL_OFF + 1024))[tl] = rsqrtf(sq * (1.0f / 1024.0f) + 1e-6f); }
                __syncthreads(); }
              pg8::EpiO1 E{(const LAS float*)(ldsl + CTL_OFF + 1024), (bf16_t*)(ws + WS_ACT)};
              _Pragma("unroll 1") for (int rep = 0; rep < ((PROBE & 1) ? 2 : 1); ++rep) pg8::gemm_phase<pg8::EpiO1, pg8::StaticOrder, true, true>(ldsl, g, S, E, tl); }
            GRID_BAR();
            _Pragma("unroll 1") for (int rep = ((PROBE & 4) ? 0 : 1); rep < 2; ++rep)
#ifndef NO_O2
            { PHASE_ARGS(); o2_phase(pl, lds_raw, j, tl, wv, ln, (PROBE & 4) && rep == 0); }
#endif
            GRID_BAR();
            { PHASE_ARGS(); float* ssq = (float*)(ws + WS_SSQ); bf16_t* HB = (bf16_t*)(ws + WS_HB);
              pg8::Gemm g{(const bf16_t*)(ws + WS_ACT + 48 * MB), (const bf16_t*)(ws + WS_WOUTO) + (size_t)j * 1024 * 1536, M, 1024, 1536}; pg8::StaticOrder S; S.init(M, 1024, G, (int)blockIdx.x);
              if (layer == 3) {
                  pg8::EpiFinal E{HB, pl.out, pl.final_norm, ssq, (unsigned*)(ws + WS_CTL) + 4096, (unsigned*)(ws + WS_CTL) + CW_TMO2};
                  pg8::gemm_phase<pg8::EpiFinal, pg8::StaticOrder, false, true>(ldsl, g, S, E, tl);
              } else {
                  pg8::EpiRes E{HB, ssq};
                  pg8::gemm_phase<pg8::EpiRes, pg8::StaticOrder, true, true>(ldsl, g, S, E, tl); } }
            if (layer != 3) GRID_BAR();
        }
    }
}

extern "C" void kernel_launch(void* const* d_in, const int* in_sizes, int n_in, void* d_out, int out_size, void* d_ws, size_t ws_size, hipStream_t stream) {
    static int grid = 0;
    if (grid == 0) {
        if (n_in != 22 || out_size != M * D || ws_size < WS_END) { fprintf(stderr, "kernel_launch: unexpected shapes (n_in %d out %d ws %zu)\n", n_in, out_size, ws_size); grid = -1; return; }
        int dev = 0, cus = 0, per_cu = 0;
        hipGetDevice(&dev); hipDeviceGetAttribute(&cus, hipDeviceAttributeMultiprocessorCount, dev);
        hipFuncSetAttribute((const void*)trunk_fwd, hipFuncAttributeMaxDynamicSharedMemorySize, LDS_BYTES);
        hipOccupancyMaxActiveBlocksPerMultiprocessor(&per_cu, (const void*)trunk_fwd, 512, LDS_BYTES);
        (void)hipGetLastError();
        if (per_cu < 1) { fprintf(stderr, "kernel_launch: occupancy query says %d blocks per CU\n", per_cu); per_cu = 1; }
        grid = 256;
        if (cus < 256) { fprintf(stderr, "kernel_launch: %d CUs < 256\n", cus); grid = -1; return; }
    }
    if (grid < 0) return;
    hipMemsetAsync((char*)d_ws + WS_CTL, 0, 64 * 1024, stream);
    Params p{};
    const float** pp = (const float**)&p;
    for (int i = 0; i < 22; ++i) pp[i] = (const float*)d_in[i];
    p.out = (float*)d_out; p.ws = (unsigned char*)d_ws;
    void* args[] = {&p};
    hipError_t e = hipLaunchCooperativeKernel((const void*)trunk_fwd, dim3(grid), dim3(512), args, LDS_BYTES, stream);
    if (e != hipSuccess) fprintf(stderr, "kernel_launch: cooperative launch failed: %s (grid %d)\n", hipGetErrorString(e), grid);
}
```
